# Optimizing an MI355X kernel written in HIP

```python
import math
import jax, jax.numpy as jnp
from jax import lax
import numpy as np

D_MODEL = 1024
BATCH = 4
SEQ = 4096
DEPTH = 1

CTX_LEN = 256
GRID_W = 64
CHUNK = 64
EPS = 1e-6

GLA_HEADS = 4
GLA_DK = 64
GLA_DV = 128
GLA_INNER = GLA_HEADS * GLA_DV
GLA_RANK = 16
GLA_GATE_NORM = 16.0

SSD_HEADS = 8
SSD_P = 64
SSD_N = 64
SSD_GROUPS = 2
SSD_INNER = SSD_HEADS * SSD_P
SSD_CONV_DIM = SSD_INNER + 2 * SSD_GROUPS * SSD_N
CONV_K = 3

D_MIX = GLA_INNER + SSD_INNER
D_FF = -(-8 * D_MODEL // (3 * 256)) * 256

PROJ_SIZES = (GLA_HEADS * GLA_DK, GLA_HEADS * GLA_DK, GLA_INNER, GLA_INNER, 2 * GLA_RANK,
              SSD_INNER, SSD_CONV_DIM, 2 * SSD_HEADS)
D_IN_PROJ = sum(PROJ_SIZES)
PROJ_SPLITS = tuple(int(s) for s in np.cumsum(PROJ_SIZES)[:-1])

kernel_name = "hybrid_gla_ssd_prefix_dit_layer"


def rms_norm(x, g):
    xf = x.astype(jnp.float32)
    y = xf * lax.rsqrt(jnp.mean(xf * xf, axis=-1, keepdims=True) + EPS)
    return (y * g).astype(x.dtype)


def modulate(h, shift, scale):
    return h * (1 + scale[:, None]) + shift[:, None]


def _flip(*arrs):
    return tuple(a[:, ::-1] for a in arrs)


def _chunks(a):
    b, t = a.shape[:2]
    return jnp.moveaxis(a.reshape(b, t // CHUNK, CHUNK, *a.shape[2:]), 1, 0)


def _unchunk(a):
    a = jnp.moveaxis(a, 0, 1)
    return a.reshape(a.shape[0], a.shape[1] * a.shape[2], *a.shape[3:])


def _grid_dwconv(u, w, grid_hw):
    b, t, ch = u.shape
    img = u.reshape(b, grid_hw[0], grid_hw[1], ch)
    out = lax.conv_general_dilated(img, w[:, :, None, :].astype(u.dtype), (1, 1), "SAME",
                                   dimension_numbers=("NHWC", "HWIO", "NHWC"),
                                   feature_group_count=ch)
    return out.reshape(b, t, ch)


def _gla_scan(q, k, v, g, s0):
    mask = jnp.tril(jnp.ones((CHUNK, CHUNK), bool))

    def step(s, inp):
        qc, kc, vc, gc = inp
        cum = jnp.cumsum(gc.astype(jnp.float32), axis=1)
        inter = jnp.einsum("blhk,bhkv->blhv", qc * jnp.exp(cum), s)
        diff = cum[:, :, None] - cum[:, None, :]
        decay = jnp.exp(jnp.where(mask[None, :, :, None, None], diff, -jnp.inf))
        att = jnp.einsum("bihk,bjhk,bijhk->bhij", qc, kc, decay)
        intra = jnp.einsum("bhij,bjhv->bihv", att, vc)
        tot = cum[:, -1]
        s_new = s * jnp.exp(tot)[..., None] + jnp.einsum(
            "blhk,blhv->bhkv", kc * jnp.exp(tot[:, None] - cum), vc)
        return s_new, inter + intra

    s_fin, out = lax.scan(step, s0, (_chunks(q), _chunks(k), _chunks(v), _chunks(g)))
    return _unchunk(out), s_fin


def _ssd_scan(xs, dt, a, bm, cm, s0):
    mask = jnp.tril(jnp.ones((CHUNK, CHUNK), bool))

    def step(s, inp):
        xc, dtc, ac, bc, cc = inp
        cum = jnp.cumsum(ac.astype(jnp.float32), axis=1)
        seg = cum[:, :, None] - cum[:, None, :]
        lmat = jnp.exp(jnp.where(mask[None, :, :, None], seg, -jnp.inf))
        scores = jnp.einsum("bihn,bjhn,bijh->bhij", cc, bc, lmat)
        intra = jnp.einsum("bhij,bjhp->bihp", scores, xc * dtc[..., None])
        inter = jnp.einsum("bihn,bhpn->bihp", cc, s) * jnp.exp(cum)[..., None]
        tot = cum[:, -1]
        w = (jnp.exp(tot[:, None] - cum) * dtc)[..., None]
        s_new = s * jnp.exp(tot)[:, :, None, None] + jnp.einsum("blhn,blhp->bhpn", bc * w, xc)
        return s_new, inter + intra

    s_fin, out = lax.scan(step, s0, (_chunks(xs), _chunks(dt), _chunks(a), _chunks(bm), _chunks(cm)))
    return _unchunk(out), s_fin


def _bidir(scan_fn, ctx_f, ctx_b, lat_f, lat_b, s0):
    yc_f, sc_f = scan_fn(*ctx_f, s0)
    yl_f, _ = scan_fn(*lat_f, sc_f)
    yc_b, sc_b = scan_fn(*_flip(*ctx_b), s0)
    yl_b, _ = scan_fn(*_flip(*lat_b), sc_b)
    return yc_f + yc_b[:, ::-1], yl_f + yl_b[:, ::-1]


def _stream_features(h, grid_hw, w_in, conv_w, conv_b, gla_wg_f, gla_bg_f, gla_wg_b, gla_bg_b,
                     a_log_f, a_log_b, dt_bias_f, dt_bias_b):
    b, t, _ = h.shape
    q, k, v, r, lr, z, xbc, dt_raw = jnp.split(h @ w_in, PROJ_SPLITS, axis=-1)
    heads = lambda arr, n: arr.reshape(b, t, n, -1)
    lr_f, lr_b = jnp.split(lr, 2, axis=-1)
    g_f = heads(jax.nn.log_sigmoid(lr_f @ gla_wg_f + gla_bg_f) / GLA_GATE_NORM, GLA_HEADS)
    g_b = heads(jax.nn.log_sigmoid(lr_b @ gla_wg_b + gla_bg_b) / GLA_GATE_NORM, GLA_HEADS)
    xbc = jax.nn.silu(_grid_dwconv(xbc, conv_w, grid_hw) + conv_b)
    xs, bm, cm = jnp.split(xbc, [SSD_INNER, SSD_INNER + SSD_GROUPS * SSD_N], axis=-1)
    rep = SSD_HEADS // SSD_GROUPS
    dt_f_raw, dt_b_raw = jnp.split(dt_raw, 2, axis=-1)
    dt_f = jax.nn.softplus(dt_f_raw + dt_bias_f)
    dt_b = jax.nn.softplus(dt_b_raw + dt_bias_b)
    return {
        "q": heads(q, GLA_HEADS) * GLA_DK ** -0.5,
        "k": heads(k, GLA_HEADS),
        "v": heads(v, GLA_HEADS),
        "r": r, "g_f": g_f, "g_b": g_b,
        "xs": heads(xs, SSD_HEADS),
        "bm": jnp.repeat(heads(bm, SSD_GROUPS), rep, axis=2),
        "cm": jnp.repeat(heads(cm, SSD_GROUPS), rep, axis=2),
        "dt_f": dt_f, "a_f": dt_f * -jnp.exp(a_log_f),
        "dt_b": dt_b, "a_b": dt_b * -jnp.exp(a_log_b),
        "z": z,
    }


def _merge_heads(f, y_gla, y_ssd, gla_norm, d_skip, ssd_norm, w_out):
    b, t = y_gla.shape[:2]
    o_gla = rms_norm(y_gla, gla_norm) * jax.nn.silu(f["r"]).reshape(b, t, GLA_HEADS, GLA_DV)
    y = (y_ssd + d_skip[:, None] * f["xs"]).reshape(b, t, SSD_INNER) * jax.nn.silu(f["z"])
    o_ssd = rms_norm(y.reshape(b, t, SSD_GROUPS, -1), ssd_norm.reshape(SSD_GROUPS, -1))
    o = jnp.concatenate([o_gla.reshape(b, t, GLA_INNER), o_ssd.reshape(b, t, SSD_INNER)], axis=-1)
    return o @ w_out


def hybrid_mixer(h_ctx, h_lat, rows, w_in, conv_w, conv_b, gla_wg_f, gla_bg_f, gla_wg_b, gla_bg_b,
                 gla_norm, a_log_f, a_log_b, dt_bias_f, dt_bias_b, d_skip, ssd_norm, w_out):
    per_stream = (w_in, conv_w, conv_b, gla_wg_f, gla_bg_f, gla_wg_b, gla_bg_b,
                  a_log_f, a_log_b, dt_bias_f, dt_bias_b)
    fc = _stream_features(h_ctx, (1, h_ctx.shape[1]), *per_stream)
    fl = _stream_features(h_lat, (rows, GRID_W), *per_stream)
    b = h_lat.shape[0]
    gla0 = jnp.zeros((b, GLA_HEADS, GLA_DK, GLA_DV), jnp.float32)
    ssd0 = jnp.zeros((b, SSD_HEADS, SSD_P, SSD_N), jnp.float32)
    gla_in = lambda f, d: (f["q"], f["k"], f["v"], f["g_" + d])
    ssd_in = lambda f, d: (f["xs"], f["dt_" + d], f["a_" + d], f["bm"], f["cm"])
    gla_c, gla_l = _bidir(_gla_scan, gla_in(fc, "f"), gla_in(fc, "b"),
                          gla_in(fl, "f"), gla_in(fl, "b"), gla0)
    ssd_c, ssd_l = _bidir(_ssd_scan, ssd_in(fc, "f"), ssd_in(fc, "b"),
                          ssd_in(fl, "f"), ssd_in(fl, "b"), ssd0)
    y_ctx = _merge_heads(fc, gla_c, ssd_c, gla_norm, d_skip, ssd_norm, w_out)
    y_lat = _merge_heads(fl, gla_l, ssd_l, gla_norm, d_skip, ssd_norm, w_out)
    return y_ctx, y_lat


def swiglu(h, w_gate, w_up, w_down):
    return (jax.nn.silu(h @ w_gate) * (h @ w_up)) @ w_down


def setup_inputs(seed: int = 0) -> dict:
    key = jax.random.key(seed)
    ks = jax.random.split(key, 28)
    f32 = jnp.float32
    nrm = lambda k, shape, scale: jax.random.normal(k, shape, f32) * scale
    gain = lambda k, shape: 1.0 + 0.1 * jax.random.normal(k, shape, f32)

    def dt_bias(k):
        dt = jnp.exp(jax.random.uniform(k, (DEPTH, SSD_HEADS), f32, math.log(1e-3), math.log(1e-1)))
        return dt + jnp.log(-jnp.expm1(-dt))

    def a_log(k):
        return jnp.log(jax.random.uniform(k, (DEPTH, SSD_HEADS), f32, 1.0, 16.0))

    return {
        "x": nrm(ks[0], (BATCH, SEQ, D_MODEL), 1.0),
        "c": nrm(ks[1], (BATCH, D_MODEL), 1.0),
        "ctx": nrm(ks[2], (BATCH, CTX_LEN, D_MODEL), 1.0),
        "c_ctx": nrm(ks[3], (D_MODEL,), 0.5),
        "w_mod": nrm(ks[4], (DEPTH, D_MODEL, 6 * D_MODEL), D_MODEL ** -0.5),
        "b_mod": nrm(ks[5], (DEPTH, 6 * D_MODEL), 0.02),
        "norm_mix_pre": gain(ks[6], (DEPTH, D_MODEL)),
        "norm_mix_post": gain(ks[7], (DEPTH, D_MODEL)),
        "norm_ffn_pre": gain(ks[8], (DEPTH, D_MODEL)),
        "norm_ffn_post": gain(ks[9], (DEPTH, D_MODEL)),
        "w_in": nrm(ks[10], (DEPTH, D_MODEL, D_IN_PROJ), D_MODEL ** -0.5),
        "conv_w": nrm(ks[11], (DEPTH, CONV_K, CONV_K, SSD_CONV_DIM), (CONV_K * CONV_K) ** -0.5),
        "conv_b": nrm(ks[12], (DEPTH, SSD_CONV_DIM), 0.02),
        "gla_wg_f": nrm(ks[13], (DEPTH, GLA_RANK, GLA_HEADS * GLA_DK), GLA_RANK ** -0.5),
        "gla_bg_f": nrm(ks[14], (DEPTH, GLA_HEADS * GLA_DK), 0.1),
        "gla_wg_b": nrm(ks[15], (DEPTH, GLA_RANK, GLA_HEADS * GLA_DK), GLA_RANK ** -0.5),
        "gla_bg_b": nrm(ks[16], (DEPTH, GLA_HEADS * GLA_DK), 0.1),
        "gla_norm": gain(ks[17], (DEPTH, GLA_DV)),
        "a_log_f": a_log(ks[18]),
        "a_log_b": a_log(ks[19]),
        "dt_bias_f": dt_bias(ks[20]),
        "dt_bias_b": dt_bias(ks[21]),
        "d_skip": gain(ks[22], (DEPTH, SSD_HEADS)),
        "ssd_norm": gain(ks[23], (DEPTH, SSD_INNER)),
        "w_out": nrm(ks[24], (DEPTH, D_MIX, D_MODEL), D_MIX ** -0.5),
        "w_gate": nrm(ks[25], (DEPTH, D_MODEL, D_FF), D_MODEL ** -0.5),
        "w_up": nrm(ks[26], (DEPTH, D_MODEL, D_FF), D_MODEL ** -0.5),
        "w_down": nrm(ks[27], (DEPTH, D_FF, D_MODEL), D_FF ** -0.5),
    }


def reference(x, c, ctx, c_ctx, w_mod, b_mod, norm_mix_pre, norm_mix_post, norm_ffn_pre, norm_ffn_post,
              w_in, conv_w, conv_b, gla_wg_f, gla_bg_f, gla_wg_b, gla_bg_b, gla_norm,
              a_log_f, a_log_b, dt_bias_f, dt_bias_b, d_skip, ssd_norm, w_out, w_gate, w_up, w_down):
    rows = x.shape[1] // GRID_W
    x_lat, x_ctx = x, ctx
    for layer in range(DEPTH):
        m_lat = jnp.split(jax.nn.silu(c) @ w_mod[layer] + b_mod[layer], 6, axis=-1)
        m_ctx = jnp.split(jax.nn.silu(c_ctx)[None] @ w_mod[layer] + b_mod[layer], 6, axis=-1)

        h_lat = modulate(rms_norm(x_lat, norm_mix_pre[layer]), m_lat[0], m_lat[1])
        h_ctx = modulate(rms_norm(x_ctx, norm_mix_pre[layer]), m_ctx[0], m_ctx[1])
        y_ctx, y_lat = hybrid_mixer(
            h_ctx, h_lat, rows, w_in[layer], conv_w[layer], conv_b[layer],
            gla_wg_f[layer], gla_bg_f[layer], gla_wg_b[layer], gla_bg_b[layer], gla_norm[layer],
            a_log_f[layer], a_log_b[layer], dt_bias_f[layer], dt_bias_b[layer],
            d_skip[layer], ssd_norm[layer], w_out[layer])

        x_lat = x_lat + m_lat[2][:, None] * rms_norm(y_lat, norm_mix_post[layer])
        f_lat = swiglu(modulate(rms_norm(x_lat, norm_ffn_pre[layer]), m_lat[3], m_lat[4]),
                       w_gate[layer], w_up[layer], w_down[layer])
        x_lat = x_lat + m_lat[5][:, None] * rms_norm(f_lat, norm_ffn_post[layer])

        if layer + 1 < DEPTH:
            x_ctx = x_ctx + m_ctx[2][:, None] * rms_norm(y_ctx, norm_mix_post[layer])
            f_ctx = swiglu(modulate(rms_norm(x_ctx, norm_ffn_pre[layer]), m_ctx[3], m_ctx[4]),
                           w_gate[layer], w_up[layer], w_down[layer])
            x_ctx = x_ctx + m_ctx[5][:, None] * rms_norm(f_ctx, norm_ffn_post[layer])
    return x_lat
```

```cpp
#include <hip/hip_runtime.h>
#include <hip/hip_cooperative_groups.h>
#include <cstdio>
#include <cstdint>
namespace cg = cooperative_groups;
namespace pg8 {
#define PG8_LAS __attribute__((address_space(3)))
typedef unsigned short bf16_t;
typedef short bf16x8 __attribute__((ext_vector_type(8)));
typedef float f32x4 __attribute__((ext_vector_type(4)));
typedef unsigned u32x4 __attribute__((ext_vector_type(4)));
constexpr int BM = 256, BK = 64, HALF = 128, HTB = HALF * BK * 2  , STAGE_BYTES = 8 * HTB, NXCD = 8, WGM = 8;

__host__ __device__ __forceinline__ int lds_byte(int r, int c) { const int st = (r >> 4) * 2 + (c >> 5), rr = r & 15, cc = c & 31, ob = rr * 64 + cc * 2; return st * 1024 + (ob ^ (((ob >> 9) & 1) << 5)); }
__host__ __device__ __forceinline__ void stage_rc(int b, int& R, int& C) { const int st = b / 1024, sb = b % 1024, swz = sb ^ (((sb >> 9) & 1) << 5); R = (st >> 1) * 16 + swz / 64; C = (st & 1) * 32 + (swz % 64) / 2; }
__host__ __device__ __forceinline__ int perm32(int rho) { const int n = rho >> 4, i = rho & 15; return 8 * (i >> 2) + 4 * n + (i & 3); }

struct Unit { int pm, pn; };
struct Gemm { const bf16_t* A; const bf16_t* Bt; int M, N, K; };

struct StaticOrder {
    int nM, nN, nwg, G, c;
    __host__ __device__ void init(int M, int N, int G_, int c_) { nM = M / BM; nN = N / BM; nwg = nM * nN; G = G_; c = c_; }
    __host__ __device__ bool next(int i, Unit& u) const {
        const long L = (long)i * G + c; if (L >= nwg) return false;
        int wgid = (int)L; { const int q = nwg / NXCD, r = nwg % NXCD, xcd = wgid % NXCD, off = wgid / NXCD; wgid = (xcd < r ? xcd * (q + 1) : r * (q + 1) + (xcd - r) * q) + off; }
        const int nig = WGM * nN, gid = wgid / nig, fm = gid * WGM, gsz = (nM - fm) < WGM ? (nM - fm) : WGM;
        u.pm = fm + ((wgid % nig) % gsz); u.pn = (wgid % nig) / gsz; return true;
    }
    __device__ __forceinline__ void a_ready(const Unit&) const {}
    __device__ __forceinline__ void done(const Unit&) const {}
};

__device__ __forceinline__ unsigned cvt_pk_bf16(float lo, float hi) { unsigned r; asm volatile("v_cvt_pk_bf16_f32 %0, %1, %2" : "=v"(r) : "v"(lo), "v"(hi)); return r; }
typedef float f32x2 __attribute__((ext_vector_type(2)));
__device__ __forceinline__ float silu_f(float x) { return x / (1.0f + __expf(-x)); }
struct EpiProj {
    static constexpr bool PERM = true, AFTER_DRAIN = false;
    bf16_t* O;
    __device__ __forceinline__ void operator()(const f32x4 (&acc)[2][2][4][2], const Unit& u, int wr, int wc, int fr, int fq) const {
        const int row0 = u.pm * BM + wr * 64 + fr;
#pragma unroll
        for (int bj = 0; bj < 2; ++bj) {
            const int col0 = u.pn * BM + bj * HALF + wc * 32 + 8 * fq;
            if (col0 >= 2880) continue;
            const float sc = (col0 < 256) ? 0.125f : 1.0f;
#pragma unroll
            for (int ai = 0; ai < 2; ++ai)
#pragma unroll
                for (int m = 0; m < 4; ++m) {
                    const f32x4 v0 = acc[ai][bj][m][0] * sc, v1 = acc[ai][bj][m][1] * sc;
                    u32x4 w; w.x = cvt_pk_bf16(v0[0], v0[1]); w.y = cvt_pk_bf16(v0[2], v0[3]); w.z = cvt_pk_bf16(v1[0], v1[1]); w.w = cvt_pk_bf16(v1[2], v1[3]);
                    *(u32x4*)(O + (size_t)(row0 + ai * HALF + m * 16) * 2880 + col0) = w;
                }
        }
    }
};
struct EpiF32 {
    static constexpr bool PERM = false, AFTER_DRAIN = false;
    float* O;
    __device__ __forceinline__ void operator()(const f32x4 (&acc)[2][2][4][2], const Unit& u, int wr, int wc, int fr, int fq) const {
        const int row0 = u.pm * BM + wr * 64 + fr, col0 = u.pn * BM + wc * 32 + 4 * fq;
#pragma unroll
        for (int ai = 0; ai < 2; ++ai)
#pragma unroll
            for (int m = 0; m < 4; ++m) {
                float* rowp = O + (size_t)(row0 + ai * HALF + m * 16) * 1024 + col0;
#pragma unroll
                for (int bj = 0; bj < 2; ++bj)
#pragma unroll
                    for (int n = 0; n < 2; ++n) *(f32x4*)(rowp + bj * HALF + n * 16) = acc[ai][bj][m][n];
            }
    }
};
struct EpiSwiglu {
    static constexpr bool PERM = true, AFTER_DRAIN = false;
    bf16_t* O;
    __device__ __forceinline__ void operator()(const f32x4 (&acc)[2][2][4][2], const Unit& u, int wr, int wc, int fr, int fq) const {
        const int row0 = u.pm * BM + wr * 64 + fr, col0 = u.pn * HALF + wc * 32 + 8 * fq;
#pragma unroll
        for (int ai = 0; ai < 2; ++ai)
#pragma unroll
            for (int m = 0; m < 4; ++m) {
                float r[8];
#pragma unroll
                for (int n = 0; n < 2; ++n)
#pragma unroll
                    for (int j = 0; j < 4; ++j) r[n * 4 + j] = silu_f(acc[ai][0][m][n][j]) * acc[ai][1][m][n][j];
                u32x4 w; w.x = cvt_pk_bf16(r[0], r[1]); w.y = cvt_pk_bf16(r[2], r[3]); w.z = cvt_pk_bf16(r[4], r[5]); w.w = cvt_pk_bf16(r[6], r[7]);
                *(u32x4*)(O + (size_t)(row0 + ai * HALF + m * 16) * 2816 + col0) = w;
            }
    }
};

template <class Epi, class Sched, bool ALIGN_EPI = false, bool SP2 = false>
__device__ __forceinline__ void gemm_phase(PG8_LAS unsigned char* lds, const Gemm g, const Sched& S, const Epi& E) {
    int tid_l_ = threadIdx.x; asm volatile("" : "+v"(tid_l_));
    const int tid = tid_l_, wid = __builtin_amdgcn_readfirstlane(tid >> 6), lane = tid & 63, wr = wid >> 2, wc = wid & 3, fr = lane & 15, fq = lane >> 4;
    const int K = g.K, nt = K / BK;
    unsigned voffA[2], voffB[2];
#pragma unroll
    for (int i = 0; i < 2; ++i) { int R, C; stage_rc(tid * 16 + i * 8192, R, C); const int Rb = Epi::PERM ? ((R & ~31) + perm32(R & 31)) : R;
        voffA[i] = (unsigned)(R * K + C) * 2u; voffB[i] = (unsigned)(Rb * K + C) * 2u; }
    const size_t kstep = (size_t)(BK * 2);
    const size_t hstep = (size_t)HALF * K * 2;
    const size_t tstep = 2 * hstep;
    const unsigned ldsw = (unsigned)wid * 1024u;
    const int aoff = lds_byte(wr * 64 + fr, fq * 8), boff = lds_byte(wc * 32 + fr, fq * 8);
#define PG8_SA(b, h) (((b) * 2 + (h)) * HTB)
#define PG8_SB(b, h) ((4 + (b) * 2 + (h)) * HTB)
#define PG8_STAGE(bufoff, gbase, voff) do { _Pragma("unroll") for (int _i = 0; _i < 2; ++_i) \
        __builtin_amdgcn_global_load_lds((const unsigned*)((const char*)(gbase) + (voff)[_i]), (PG8_LAS unsigned*)(lds + (bufoff) + ldsw + _i * 8192), 16, 0, 0); } while (0)
#define PG8_LDA(dst, b, h) do { _Pragma("unroll") for (int m = 0; m < 4; ++m) _Pragma("unroll") for (int k = 0; k < 2; ++k) dst[m][k] = *(const PG8_LAS bf16x8*)(lds + PG8_SA(b, h) + aoff + m * 2048 + k * 1024); } while (0)
#define PG8_LDB(dst, b, h) do { _Pragma("unroll") for (int n = 0; n < 2; ++n) _Pragma("unroll") for (int k = 0; k < 2; ++k) dst[n][k] = *(const PG8_LAS bf16x8*)(lds + PG8_SB(b, h) + boff + n * 2048 + k * 1024); } while (0)
#define PG8_MMA(ai, bj, At, Bt) do { __builtin_amdgcn_s_setprio(1); _Pragma("unroll") for (int m = 0; m < 4; ++m) _Pragma("unroll") for (int n = 0; n < 2; ++n) _Pragma("unroll") for (int k = 0; k < 2; ++k) \
        acc[ai][bj][m][n] = __builtin_amdgcn_mfma_f32_16x16x32_bf16(Bt[n][k], At[m][k], acc[ai][bj][m][n], 0, 0, 0); __builtin_amdgcn_s_setprio(0); } while (0)
#define PG8_WAIT_V(n) asm volatile("s_waitcnt vmcnt(" #n ")" ::: "memory")
#define PG8_WAIT_L(n) asm volatile("s_waitcnt lgkmcnt(" #n ")" ::: "memory")
#define PG8_BAR __builtin_amdgcn_s_barrier()
#define PG8_SCHED __builtin_amdgcn_sched_barrier(0)
    Unit cur, nxt; int ui = 0;
    if (!S.next(0, cur)) return;
    f32x4 acc[2][2][4][2];
#pragma unroll
    for (int a = 0; a < 2; ++a)
#pragma unroll
        for (int b = 0; b < 2; ++b)
#pragma unroll
            for (int m = 0; m < 4; ++m)
#pragma unroll
                for (int n = 0; n < 2; ++n) acc[a][b][m][n] = (f32x4){0.f, 0.f, 0.f, 0.f};
    bf16x8 At[4][2], B0[2][2], B1[2][2];
    const char* cA = (const char*)g.A + (size_t)cur.pm * tstep; const char* cB = (const char*)g.Bt + (size_t)cur.pn * tstep;
    S.a_ready(cur);
    if constexpr (SP2) {
        PG8_STAGE(PG8_SB(0, 0), cB, voffB); PG8_STAGE(PG8_SB(0, 1), cB + hstep, voffB); PG8_STAGE(PG8_SA(0, 0), cA, voffA); PG8_STAGE(PG8_SA(0, 1), cA + hstep, voffA);
        if (wr == 1) PG8_BAR;
        PG8_WAIT_V(2); PG8_BAR;
        PG8_STAGE(PG8_SB(1, 0), cB + kstep, voffB); PG8_STAGE(PG8_SA(1, 0), cA + kstep, voffA); PG8_STAGE(PG8_SB(1, 1), cB + hstep + kstep, voffB);
        PG8_WAIT_V(6); PG8_BAR;
    } else {
        PG8_STAGE(PG8_SB(0, 0), cB, voffB); PG8_STAGE(PG8_SA(0, 0), cA, voffA); PG8_STAGE(PG8_SB(0, 1), cB + hstep, voffB); PG8_STAGE(PG8_SA(0, 1), cA + hstep, voffA);
        if (wr == 1) PG8_BAR;
        PG8_WAIT_V(4); PG8_BAR;
        PG8_STAGE(PG8_SB(1, 0), cB + kstep, voffB); PG8_STAGE(PG8_SA(1, 0), cA + kstep, voffA); PG8_STAGE(PG8_SB(1, 1), cB + hstep + kstep, voffB);
        PG8_WAIT_V(6); PG8_BAR;
    }
    for (;;) {
        const bool has_next = S.next(ui + 1, nxt);
        const char* nA = has_next ? (const char*)g.A + (size_t)nxt.pm * tstep : cA; const char* nB = has_next ? (const char*)g.Bt + (size_t)nxt.pn * tstep : cB;
        for (int t = 0; t < nt; t += 2) {
            const bool last = (t == nt - 2);
            const char* a1 = cA + (size_t)(t + 1) * kstep;
            const char* a2 = last ? nA : cA + (size_t)(t + 2) * kstep; const char* b2 = last ? nB : cB + (size_t)(t + 2) * kstep;
            const char* a3 = a2 + kstep; const char* b3 = b2 + kstep;
            if (last && has_next) S.a_ready(nxt);
            if constexpr (SP2) {
            PG8_LDB(B0, 0, 0); PG8_LDB(B1, 0, 1); PG8_SCHED; PG8_LDA(At, 0, 0); PG8_STAGE(PG8_SA(1, 1), a1 + hstep, voffA);
            PG8_WAIT_V(8); PG8_WAIT_L(0); PG8_BAR; PG8_MMA(0, 0, At, B0); PG8_MMA(0, 1, At, B1); PG8_BAR; PG8_SCHED;
            PG8_LDA(At, 0, 1); PG8_STAGE(PG8_SB(0, 0), b2, voffB); PG8_STAGE(PG8_SB(0, 1), b2 + hstep, voffB); PG8_STAGE(PG8_SA(0, 0), a2, voffA);
            PG8_WAIT_V(8); PG8_WAIT_L(0); PG8_BAR; PG8_MMA(1, 0, At, B0); PG8_MMA(1, 1, At, B1); PG8_BAR; PG8_SCHED;
            PG8_LDB(B0, 1, 0); PG8_LDB(B1, 1, 1); PG8_SCHED; PG8_LDA(At, 1, 0); PG8_STAGE(PG8_SA(0, 1), a2 + hstep, voffA);
            PG8_WAIT_V(8); PG8_WAIT_L(0); PG8_BAR; PG8_MMA(0, 0, At, B0); PG8_MMA(0, 1, At, B1); PG8_BAR; PG8_SCHED;
            PG8_LDA(At, 1, 1); PG8_STAGE(PG8_SB(1, 0), b3, voffB); PG8_STAGE(PG8_SB(1, 1), b3 + hstep, voffB); PG8_STAGE(PG8_SA(1, 0), a3, voffA);
            PG8_WAIT_V(8); PG8_WAIT_L(0); PG8_BAR; PG8_MMA(1, 0, At, B0); PG8_MMA(1, 1, At, B1); PG8_BAR; PG8_SCHED;
            } else {
            PG8_LDB(B0, 0, 0); PG8_SCHED; PG8_LDA(At, 0, 0); PG8_STAGE(PG8_SA(1, 1), a1 + hstep, voffA);
            PG8_WAIT_L(8); PG8_BAR; PG8_WAIT_L(0); PG8_MMA(0, 0, At, B0); PG8_BAR; PG8_SCHED;
            PG8_LDB(B1, 0, 1); PG8_STAGE(PG8_SB(0, 0), b2, voffB);
            PG8_BAR; PG8_WAIT_L(0); PG8_MMA(0, 1, At, B1); PG8_BAR;
            PG8_LDA(At, 0, 1); PG8_STAGE(PG8_SA(0, 0), a2, voffA);
            PG8_BAR; PG8_WAIT_L(0); PG8_MMA(1, 0, At, B0); PG8_BAR; PG8_SCHED;
            PG8_STAGE(PG8_SB(0, 1), b2 + hstep, voffB);
            PG8_WAIT_V(6); PG8_BAR; PG8_MMA(1, 1, At, B1); PG8_BAR;
            PG8_LDB(B0, 1, 0); PG8_SCHED; PG8_LDA(At, 1, 0); PG8_STAGE(PG8_SA(0, 1), a2 + hstep, voffA);
            PG8_WAIT_L(8); PG8_BAR; PG8_WAIT_L(0); PG8_MMA(0, 0, At, B0); PG8_BAR; PG8_SCHED;
            PG8_LDB(B1, 1, 1); PG8_STAGE(PG8_SB(1, 0), b3, voffB);
            PG8_BAR; PG8_WAIT_L(0); PG8_MMA(0, 1, At, B1); PG8_BAR;
            PG8_LDA(At, 1, 1); PG8_STAGE(PG8_SA(1, 0), a3, voffA);
            PG8_BAR; PG8_WAIT_L(0); PG8_MMA(1, 0, At, B0); PG8_BAR; PG8_SCHED;
            PG8_STAGE(PG8_SB(1, 1), b3 + hstep, voffB);
            PG8_WAIT_V(6); PG8_BAR; PG8_MMA(1, 1, At, B1); PG8_BAR;
            }
        }
        if constexpr (ALIGN_EPI) { if (wr == 0) PG8_BAR; }
        if constexpr (!Epi::AFTER_DRAIN) { E(acc, cur, wr, wc, fr, fq); S.done(cur); }
        if (!has_next) break;
#pragma unroll
        for (int a = 0; a < 2; ++a)
#pragma unroll
            for (int b = 0; b < 2; ++b)
#pragma unroll
                for (int m = 0; m < 4; ++m)
#pragma unroll
                    for (int n = 0; n < 2; ++n) acc[a][b][m][n] = (f32x4){0.f, 0.f, 0.f, 0.f};
        cur = nxt; cA = nA; cB = nB; ++ui;
        if constexpr (ALIGN_EPI) { if (wr == 1) PG8_BAR; }
    }
    PG8_WAIT_V(0);
    if constexpr (!ALIGN_EPI) { if (wr == 0) PG8_BAR; }
    PG8_BAR;
    if constexpr (Epi::AFTER_DRAIN) { E.fused(acc, cur, wr, wc, fr, fq, lds, wid, lane); S.done(cur); }
#undef PG8_SA
#undef PG8_SB
#undef PG8_STAGE
#undef PG8_LDA
#undef PG8_LDB
#undef PG8_MMA
#undef PG8_WAIT_V
#undef PG8_WAIT_L
#undef PG8_BAR
#undef PG8_SCHED
}
}
#define LAS __attribute__((address_space(3)))
typedef unsigned short bf16;
typedef unsigned v4u __attribute__((ext_vector_type(4)));
typedef unsigned v2u __attribute__((ext_vector_type(2)));
typedef float f32x4 __attribute__((ext_vector_type(4)));
constexpr int NW = 8, NT = 512, GRID = 256;
constexpr int D = 1024, SEQ = 4096, NB = 4, CTX = 256, MLAT = NB * SEQ, MCTX = NB * CTX, MALL = MLAT + MCTX;
constexpr int NCH = MALL / 64, NCHL = MLAT / 64;
constexpr int LDP = 2880;
constexpr int PQ = 0, PK = 256, PV = 512, PR = 1024, PZ = 1536, PX = 2048, PLR = 2816, PDT = 2848;
constexpr int DFF = 2816, DIN = 2864;
constexpr float EPS = 1e-6f;
constexpr size_t MiB = 1u << 20;
constexpr size_t WS_MODP = 1 * MiB, WS_MODF = 14 * MiB;
constexpr size_t WS_WIN = 2 * MiB, WS_WOUT = 8 * MiB, WS_SMALL = 10 * MiB;
constexpr size_t WS_R1 = 16 * MiB, WS_PROJ = 50 * MiB, WS_G = 146 * MiB, WS_ST = 180 * MiB, WS_END = 248 * MiB;
constexpr size_t SM_DT = 0, SM_A = 2 * (size_t)MALL * 8 * 4, SM_DECG = 4 * (size_t)MALL * 8 * 4, SM_DECS = SM_DECG + (size_t)NCH * 2 * 256 * 4;
constexpr int LDS_BYTES = 147456;

struct Args { const float* in[28]; float* out; unsigned char* ws; };

__device__ __forceinline__ unsigned f2bf(float f) { unsigned u = __builtin_bit_cast(unsigned, f); return (u + 0x7fffu + ((u >> 16) & 1u)) >> 16; }
__device__ __forceinline__ unsigned pk2(float lo, float hi) { return f2bf(lo) | (f2bf(hi) << 16); }
__device__ __forceinline__ float bflo(unsigned u) { return __builtin_bit_cast(float, u << 16); }
__device__ __forceinline__ float bfhi(unsigned u) { return __builtin_bit_cast(float, u & 0xffff0000u); }
__device__ __forceinline__ float bf1(bf16 h) { return __builtin_bit_cast(float, ((unsigned)h) << 16); }
__device__ __forceinline__ float silu(float x) { return x / (1.0f + __expf(-x)); }
__device__ __forceinline__ float logsigmoid(float x) { return fminf(x, 0.f) - log1pf(__expf(-fabsf(x))); }
__device__ __forceinline__ float softplus(float x) { return fmaxf(x, 0.f) + log1pf(__expf(-fabsf(x))); }
__device__ __forceinline__ float shx(float v, int o, int lane) { return __builtin_bit_cast(float, __builtin_amdgcn_ds_bpermute((lane ^ o) << 2, __builtin_bit_cast(int, v))); }
#define LDS_WAIT() asm volatile("s_waitcnt lgkmcnt(0)" ::: "memory")

__device__ __forceinline__ void transpose_item(const float* W, int K, int N, bf16* WT, int dst_row0, int k0, int n0, LAS float* scr, int lane) {
#pragma unroll
    for (int i = 0; i < 32; ++i) { const int kk = 2 * i + (lane >> 5), n = n0 + (lane & 31); scr[kk * 33 + (lane & 31)] = (n < N) ? W[(size_t)(k0 + kk) * N + n] : 0.f; }
    LDS_WAIT(); asm volatile("" ::: "memory");
    const int c = lane & 7;
#pragma unroll
    for (int j = 0; j < 4; ++j) { const int n = (lane >> 3) + 8 * j; const LAS float* s = scr + (8 * c) * 33 + n;
        v4u o; o.x = pk2(s[0 * 33], s[1 * 33]); o.y = pk2(s[2 * 33], s[3 * 33]); o.z = pk2(s[4 * 33], s[5 * 33]); o.w = pk2(s[6 * 33], s[7 * 33]);
        *(v4u*)(WT + (size_t)(dst_row0 + n) * K + k0 + 8 * c) = o; }
    LDS_WAIT(); asm volatile("" ::: "memory");
}

#define XB_TMO      128
#define XB_XCNT(j)  (256  + 64 * (j))
#define XB_XSUB(j)  (1280 + 64 * (j))
#define XB_XGEN(j)  (2304 + 64 * (j))
#define XB_TOP      3328
#define XB_TOPGEN   3392
#define XCD_BAR_WORDS 3456
#define XB_SPIN_CAP (1u << 18)

__device__ __forceinline__ unsigned xb_ld(unsigned* p)              { return __hip_atomic_load(p, __ATOMIC_RELAXED, __HIP_MEMORY_SCOPE_AGENT); }
__device__ __forceinline__ unsigned xb_add(unsigned* p, unsigned v) { return __hip_atomic_fetch_add(p, v, __ATOMIC_RELAXED, __HIP_MEMORY_SCOPE_AGENT); }
__device__ __forceinline__ unsigned xb_xcc_id() { return (unsigned)__builtin_amdgcn_s_getreg((3 << 11) | 20) & 0xFu; }
#define XB_SPIN(cond, bar) do { unsigned _sp = 0; while (cond) { __builtin_amdgcn_s_sleep(1); \
    if ((++_sp & 255u) == 0u) { if (xb_ld(&(bar)[XB_TMO])) break; if (_sp > XB_SPIN_CAP) { atomicAdd(&(bar)[XB_TMO], 1u); break; } } } } while (0)

struct XcdBarrier {
    unsigned* bar; unsigned x;
    volatile LAS unsigned* st;
};

__device__ __forceinline__ XcdBarrier xcd_barrier_post(unsigned* bar, volatile LAS unsigned* st) {
    XcdBarrier b; b.bar = bar; b.x = xb_xcc_id(); b.st = st;
    if (threadIdx.x == 0) (void)xb_add(&bar[XB_XCNT(b.x)], 1u);
    return b;
}
__device__ __forceinline__ void xcd_barrier_complete(unsigned* bar, unsigned x, unsigned& nloc, unsigned& nx) {
    const unsigned G = gridDim.x * gridDim.y * gridDim.z;
    unsigned sum, cnt, mine, sp = 0u;
    for (;;) {
        sum = 0u; cnt = 0u; mine = 0u;
#pragma unroll
        for (unsigned j = 0; j < 16; ++j) { const unsigned c = xb_ld(&bar[XB_XCNT(j)]); sum += c; cnt += (c > 0u) ? 1u : 0u; mine = (j == x) ? c : mine; }
        if (sum == G) break;
        __builtin_amdgcn_s_sleep(1);
        if ((++sp & 255u) == 0u) { if (xb_ld(&bar[XB_TMO])) break; if (sp > XB_SPIN_CAP) { atomicAdd(&bar[XB_TMO], 1u); break; } }
    }
    nloc = mine > 0u ? mine : 1u; nx = cnt > 0u ? cnt : 1u;
}

__device__ __forceinline__ void xcd_barrier(const XcdBarrier& b) {
    asm volatile("s_waitcnt vmcnt(0)" ::: "memory");
    __syncthreads();
    if (threadIdx.x == 0) {
        unsigned* bar = b.bar;
        __builtin_amdgcn_s_waitcnt(0);
        unsigned nloc = b.st[0], nx = b.st[1];
        if (nloc == 0u) { xcd_barrier_complete(bar, b.x, nloc, nx); b.st[0] = nloc; b.st[1] = nx; }
        const unsigned old = xb_add(&bar[XB_XSUB(b.x)], 1u);
        const unsigned gen = old / nloc;
        if (old + 1u == (gen + 1u) * nloc) {
            __builtin_amdgcn_fence(__ATOMIC_RELEASE, "agent");
            asm volatile("s_waitcnt vmcnt(0)" ::: "memory");
            const unsigned og = xb_add(&bar[XB_TOP], 1u);
            const unsigned tg = og / nx;
            if (og + 1u == (tg + 1u) * nx) xb_add(&bar[XB_TOPGEN], 1u);
            else XB_SPIN(xb_ld(&bar[XB_TOPGEN]) == tg, bar);
            __builtin_amdgcn_fence(__ATOMIC_ACQUIRE, "agent");
            xb_add(&bar[XB_XGEN(b.x)], 1u);
            asm volatile("s_waitcnt vmcnt(0)" ::: "memory");
        } else {
            XB_SPIN(xb_ld(&bar[XB_XGEN(b.x)]) == gen, bar);
            __builtin_amdgcn_fence(__ATOMIC_ACQUIRE, "agent");
            asm volatile("s_waitcnt vmcnt(0)" ::: "memory");
        }
    }
    __syncthreads();
}

__device__ __forceinline__ int chain_chunk(int b, int d, int st) {
    if (st < 4) return 256 + 4 * b + (d ? 3 - st : st);
    const int c = st - 4; return 64 * b + (d ? 63 - c : c);
}

typedef short bf16x8 __attribute__((ext_vector_type(8)));
#define MFMA16(a, b, c) __builtin_amdgcn_mfma_f32_16x16x32_bf16((a), (b), (c), 0, 0, 0)
constexpr int RS = 144;
__device__ __forceinline__ bf16x8 ldsfrag(LAS unsigned char* base, int row, int ks, int lq) { return *(const LAS bf16x8*)(base + row * RS + ks * 64 + lq * 16); }
__device__ __forceinline__ float bperm(float v, int srclane) { return __builtin_bit_cast(float, __builtin_amdgcn_ds_bpermute(srclane << 2, __builtin_bit_cast(int, v))); }

template <int PASS>
__device__ __forceinline__ void gla_unit(LAS unsigned char* lds, int ch, int h, const bf16* PROJ, const float* GT, bf16* STG, float* DECG, bf16* OMIX, const float* gla_norm) {
    int tid_o_ = threadIdx.x; asm volatile("" : "+v"(tid_o_)); const int tid = tid_o_, lane = tid & 63, wave = __builtin_amdgcn_readfirstlane(tid >> 6);
    const int lr = lane & 15, lq = lane >> 4;
    LAS unsigned char* QE0 = lds; LAS unsigned char* KE0 = lds + 9216; LAS unsigned char* QE1 = lds + 18432; LAS unsigned char* KE1 = lds + 27648;
    LAS unsigned char* KT0 = lds + 36864; LAS unsigned char* KT1 = lds + 46080; LAS unsigned char* VT = lds + 55296; LAS unsigned char* Pm = lds + 73728;
    LAS float* OFFS = (LAS float*)(lds + 82944); LAS float* RED = (LAS float*)(lds + 84992);
    const size_t m0 = (size_t)64 * ch;
    {
        const int kk = tid & 63, qt = (tid >> 6) & 3, d = tid >> 8;
        const float* gp = GT + ((size_t)d * MALL + m0 + 16 * qt) * 256 + h * 64 + kk;
        const bf16* qp = PROJ + (m0 + 16 * qt) * LDP + PQ + h * 64 + kk; const bf16* kp = PROJ + (m0 + 16 * qt) * LDP + PK + h * 64 + kk;
        float c[16], kv[16], qv[16];
#pragma unroll
        for (int jj = 0; jj < 16; ++jj) { c[jj] = gp[(size_t)jj * 256]; kv[jj] = bf1(kp[(size_t)jj * LDP]); if (PASS == 1) qv[jj] = bf1(qp[(size_t)jj * LDP]); }
        if (d == 0) {
#pragma unroll
            for (int jj = 1; jj < 16; ++jj) c[jj] += c[jj - 1];
        } else {
#pragma unroll
            for (int jj = 14; jj >= 0; --jj) c[jj] += c[jj + 1];
        }
        OFFS[(d * 4 + qt) * 64 + kk] = d ? c[0] : c[15];
        { const int vcol = tid & 127, q4 = tid >> 7; const bf16* vp = PROJ + (m0 + 16 * q4) * LDP + PV + h * 128 + vcol; unsigned short vv[16];
#pragma unroll
          for (int jj = 0; jj < 16; ++jj) vv[jj] = vp[(size_t)jj * LDP];
          v4u w0, w1; w0.x = vv[0] | ((unsigned)vv[1] << 16); w0.y = vv[2] | ((unsigned)vv[3] << 16); w0.z = vv[4] | ((unsigned)vv[5] << 16); w0.w = vv[6] | ((unsigned)vv[7] << 16);
          w1.x = vv[8] | ((unsigned)vv[9] << 16); w1.y = vv[10] | ((unsigned)vv[11] << 16); w1.z = vv[12] | ((unsigned)vv[13] << 16); w1.w = vv[14] | ((unsigned)vv[15] << 16);
          *(LAS v4u*)(VT + vcol * RS + q4 * 32) = w0; *(LAS v4u*)(VT + vcol * RS + q4 * 32 + 16) = w1; }
        __syncthreads();
        float off = 0.f, tot = 0.f;
#pragma unroll
        for (int q2 = 0; q2 < 4; ++q2) { const float t = OFFS[(d * 4 + q2) * 64 + kk]; tot += t; if (d ? (q2 > qt) : (q2 < qt)) off += t; }
        if (PASS == 0) {
            unsigned pk[8];
#pragma unroll
            for (int jj = 0; jj < 16; jj += 2) pk[jj >> 1] = pk2(kv[jj] * __expf(tot - (c[jj] + off)), kv[jj + 1] * __expf(tot - (c[jj + 1] + off)));
            LAS unsigned char* KT = d ? KT1 : KT0;
            *(LAS v4u*)(KT + kk * RS + qt * 32) = (v4u){pk[0], pk[1], pk[2], pk[3]}; *(LAS v4u*)(KT + kk * RS + qt * 32 + 16) = (v4u){pk[4], pk[5], pk[6], pk[7]};
            if (qt == 0) DECG[(size_t)(ch * 2 + d) * 256 + h * 64 + kk] = __expf(tot);
        } else {
            LAS unsigned char* QE = d ? QE1 : QE0; LAS unsigned char* KE = d ? KE1 : KE0;
#pragma unroll
            for (int jj = 0; jj < 16; ++jj) { const float cu = c[jj] + off; const int tok = 16 * qt + jj;
                *(LAS unsigned short*)(QE + tok * RS + kk * 2) = (unsigned short)f2bf(qv[jj] * __expf(cu)); *(LAS unsigned short*)(KE + tok * RS + kk * 2) = (unsigned short)f2bf(kv[jj] * __expf(-cu)); }
        }
    }
    if (PASS == 0) {
        __syncthreads();
        const int d = wave & 1, kt = wave >> 1; LAS unsigned char* KT = d ? KT1 : KT0;
        const bf16x8 a0 = ldsfrag(KT, 16 * kt + lr, 0, lq), a1 = ldsfrag(KT, 16 * kt + lr, 1, lq);
        bf16* sp = STG + (size_t)((ch * 4 + h) * 2 + d) * 8192;
#pragma unroll
        for (int vt = 0; vt < 8; ++vt) { pg8::f32x4 acc = {0.f, 0.f, 0.f, 0.f};
            acc = MFMA16(a0, ldsfrag(VT, 16 * vt + lr, 0, lq), acc); acc = MFMA16(a1, ldsfrag(VT, 16 * vt + lr, 1, lq), acc);
            v2u o; o.x = pk2(acc[0], acc[1]); o.y = pk2(acc[2], acc[3]); *(v2u*)(sp + (16 * vt + lr) * 64 + 16 * kt + 4 * lq) = o; }
        __syncthreads();
    } else {
        const int it = wave & 3, vh = wave >> 2;
        bf16x8 sf[2][4][2];
#pragma unroll
        for (int d = 0; d < 2; ++d)
#pragma unroll
            for (int v4 = 0; v4 < 4; ++v4)
#pragma unroll
                for (int ks = 0; ks < 2; ++ks) sf[d][v4][ks] = *(const bf16x8*)(STG + (size_t)((ch * 4 + h) * 2 + d) * 8192 + (16 * (4 * vh + v4) + lr) * 64 + 32 * ks + 8 * lq);
        __syncthreads();
        {
            const int ait = wave >> 1;
#pragma unroll
            for (int j2 = 0; j2 < 2; ++j2) { const int jt = 2 * (wave & 1) + j2; pg8::f32x4 af = {0.f, 0.f, 0.f, 0.f}, ab = {0.f, 0.f, 0.f, 0.f};
                if (jt <= ait) { af = MFMA16(ldsfrag(KE0, 16 * jt + lr, 0, lq), ldsfrag(QE0, 16 * ait + lr, 0, lq), af); af = MFMA16(ldsfrag(KE0, 16 * jt + lr, 1, lq), ldsfrag(QE0, 16 * ait + lr, 1, lq), af); }
                if (jt >= ait) { ab = MFMA16(ldsfrag(KE1, 16 * jt + lr, 0, lq), ldsfrag(QE1, 16 * ait + lr, 0, lq), ab); ab = MFMA16(ldsfrag(KE1, 16 * jt + lr, 1, lq), ldsfrag(QE1, 16 * ait + lr, 1, lq), ab); }
                const int i = 16 * ait + lr, j0 = 16 * jt + 4 * lq; float p[4];
#pragma unroll
                for (int r = 0; r < 4; ++r) p[r] = ((j0 + r <= i) ? af[r] : 0.f) + ((j0 + r >= i) ? ab[r] : 0.f);
                v2u o; o.x = pk2(p[0], p[1]); o.y = pk2(p[2], p[3]); *(LAS v2u*)(Pm + i * RS + j0 * 2) = o; }
        }
        __syncthreads();
        pg8::f32x4 acc[4];
#pragma unroll
        for (int v4 = 0; v4 < 4; ++v4) acc[v4] = (pg8::f32x4){0.f, 0.f, 0.f, 0.f};
#pragma unroll
        for (int ks = 0; ks < 2; ++ks) { const bf16x8 bp = ldsfrag(Pm, 16 * it + lr, ks, lq), b0 = ldsfrag(QE0, 16 * it + lr, ks, lq), b1 = ldsfrag(QE1, 16 * it + lr, ks, lq);
#pragma unroll
            for (int v4 = 0; v4 < 4; ++v4) { acc[v4] = MFMA16(ldsfrag(VT, 16 * (4 * vh + v4) + lr, ks, lq), bp, acc[v4]); acc[v4] = MFMA16(sf[0][v4][ks], b0, acc[v4]); acc[v4] = MFMA16(sf[1][v4][ks], b1, acc[v4]); } }
        float ss = 0.f;
#pragma unroll
        for (int v4 = 0; v4 < 4; ++v4) ss += (acc[v4][0] * acc[v4][0] + acc[v4][1] * acc[v4][1]) + (acc[v4][2] * acc[v4][2] + acc[v4][3] * acc[v4][3]);
        ss += bperm(ss, lane ^ 16); ss += bperm(ss, lane ^ 32);
        if (lq == 0) RED[wave * 16 + lr] = ss;
        __syncthreads();
        const float rstd = rsqrtf((RED[wave * 16 + lr] + RED[(wave ^ 4) * 16 + lr]) * (1.f / 128.f) + EPS);
        const size_t m = m0 + 16 * it + lr;
#pragma unroll
        for (int v4 = 0; v4 < 4; ++v4) { const int vcol = 16 * (4 * vh + v4) + 4 * lq; const v2u rr = *(const v2u*)(PROJ + m * LDP + PR + h * 128 + vcol); const f32x4 g = *(const f32x4*)(gla_norm + vcol);
            v2u o; o.x = pk2(acc[v4][0] * rstd * g.x * silu(bflo(rr.x)), acc[v4][1] * rstd * g.y * silu(bfhi(rr.x))); o.y = pk2(acc[v4][2] * rstd * g.z * silu(bflo(rr.y)), acc[v4][3] * rstd * g.w * silu(bfhi(rr.y)));
            *(v2u*)(OMIX + m * 1024 + h * 128 + vcol) = o; }
        __syncthreads();
    }
}

template <int PASS>
__device__ __forceinline__ void ssd_unit(LAS unsigned char* lds, int ch, int g, const bf16* PROJ, const bf16* XBC, const float* At, const float* DTt, bf16* STS, float* DECS, bf16* OMIX,
                                         const float* d_skip, const float* ssd_norm) {
    int tid_o_ = threadIdx.x; asm volatile("" : "+v"(tid_o_)); const int tid = tid_o_, lane = tid & 63, wave = __builtin_amdgcn_readfirstlane(tid >> 6);
    const int lr = lane & 15, lq = lane >> 4;
    LAS unsigned char* CM = lds; LAS unsigned char* BM = lds + 9216; LAS unsigned char* BT = lds + 18432; LAS unsigned char* XT = lds + 27648;
    LAS unsigned char* Mi = lds + 64512;
    LAS float* SC = (LAS float*)(lds + 101376); LAS float* DL = (LAS float*)(lds + 101376 + 2048); LAS float* TOT = (LAS float*)(lds + 101376 + 4096); LAS float* RED = (LAS float*)(lds + 107520);
    const size_t m0 = (size_t)64 * ch;
    {
        const int d = wave >> 2, hl = wave & 3; const size_t ix = ((size_t)d * MALL + m0 + lane) * 8 + 4 * g + hl;
        float v = At[ix]; const float dt = DTt[ix];
#pragma unroll
        for (int o = 1; o < 64; o <<= 1) { const float t = bperm(v, d ? lane + o : lane - o); if (d ? (lane + o < 64) : (lane >= o)) v += t; }
        SC[wave * 64 + lane] = v; DL[wave * 64 + lane] = dt;
        if (lane == (d ? 0 : 63)) TOT[wave] = v;
    }
    if (PASS == 0) {
        { const int n = tid & 63, oct = tid >> 6; const bf16* bp = XBC + (m0 + 8 * oct) * 768 + 512 + 64 * g + n; unsigned short vv[8];
#pragma unroll
          for (int jj = 0; jj < 8; ++jj) vv[jj] = bp[(size_t)jj * 768];
          *(LAS v4u*)(BT + n * RS + oct * 16) = (v4u){vv[0] | ((unsigned)vv[1] << 16), vv[2] | ((unsigned)vv[3] << 16), vv[4] | ((unsigned)vv[5] << 16), vv[6] | ((unsigned)vv[7] << 16)}; }
        __syncthreads();
        {
            const int p = tid & 63, hl = (tid >> 6) & 3, half = tid >> 8; const bf16* xp = XBC + (m0 + 32 * half) * 768 + (4 * g + hl) * 64 + p; float xv[32];
#pragma unroll
            for (int jj = 0; jj < 32; ++jj) xv[jj] = bf1(xp[(size_t)jj * 768]);
#pragma unroll
            for (int d = 0; d < 2; ++d) { const float tot = TOT[d * 4 + hl]; const LAS float* sc = SC + (d * 4 + hl) * 64 + 32 * half; const LAS float* dl = DL + (d * 4 + hl) * 64 + 32 * half;
                LAS unsigned char* dst = XT + ((d * 4 + hl) * 64 + p) * RS + half * 64;
#pragma unroll
                for (int o8 = 0; o8 < 4; ++o8) { unsigned pk[4];
#pragma unroll
                    for (int e = 0; e < 4; ++e) { const int j0 = 8 * o8 + 2 * e; pk[e] = pk2(xv[j0] * __expf(tot - sc[j0]) * dl[j0], xv[j0 + 1] * __expf(tot - sc[j0 + 1]) * dl[j0 + 1]); }
                    *(LAS v4u*)(dst + o8 * 16) = (v4u){pk[0], pk[1], pk[2], pk[3]}; } }
            if (tid < 8) DECS[(size_t)(ch * 2 + (tid >> 2)) * 8 + 4 * g + (tid & 3)] = __expf(TOT[tid]);
        }
        __syncthreads();
        {
            const int hh = 4 * g + (wave & 3), d = wave >> 2; LAS unsigned char* XW = XT + (wave * 64) * RS; bf16* sp = STS + (size_t)((ch * 8 + hh) * 2 + d) * 4096;
#pragma unroll
            for (int nt = 0; nt < 4; ++nt) { const bf16x8 a0 = ldsfrag(BT, 16 * nt + lr, 0, lq), a1 = ldsfrag(BT, 16 * nt + lr, 1, lq);
#pragma unroll
                for (int pt = 0; pt < 4; ++pt) { pg8::f32x4 acc = {0.f, 0.f, 0.f, 0.f};
                    acc = MFMA16(a0, ldsfrag(XW, 16 * pt + lr, 0, lq), acc); acc = MFMA16(a1, ldsfrag(XW, 16 * pt + lr, 1, lq), acc);
                    v2u o; o.x = pk2(acc[0], acc[1]); o.y = pk2(acc[2], acc[3]); *(v2u*)(sp + (16 * pt + lr) * 64 + 16 * nt + 4 * lq) = o; } }
        }
        __syncthreads();
    } else {
        {
#pragma unroll
            for (int i2 = 0; i2 < 2; ++i2) { const int idx = tid + NT * i2, tok = idx >> 4, c8 = (idx & 15) * 8;
                const v4u u = *(const v4u*)(XBC + (m0 + tok) * 768 + 512 + ((c8 < 64) ? 64 * g + c8 : 128 + 64 * g + (c8 - 64)));
                *(LAS v4u*)(((c8 < 64) ? BM : CM) + tok * RS + (c8 & 63) * 2) = u; }
            const int p = tid & 63, hl = (tid >> 6) & 3, half = tid >> 8; const bf16* xp = XBC + (m0 + 32 * half) * 768 + (4 * g + hl) * 64 + p; unsigned short xv[32];
#pragma unroll
            for (int jj = 0; jj < 32; ++jj) xv[jj] = xp[(size_t)jj * 768];
            LAS unsigned char* dst = XT + (hl * 64 + p) * RS + half * 64;
#pragma unroll
            for (int o8 = 0; o8 < 4; ++o8) *(LAS v4u*)(dst + o8 * 16) = (v4u){xv[8 * o8] | ((unsigned)xv[8 * o8 + 1] << 16), xv[8 * o8 + 2] | ((unsigned)xv[8 * o8 + 3] << 16), xv[8 * o8 + 4] | ((unsigned)xv[8 * o8 + 5] << 16), xv[8 * o8 + 6] | ((unsigned)xv[8 * o8 + 7] << 16)};
        }
        const int hl = wave >> 1, ih = wave & 1, hh = 4 * g + hl;
        bf16x8 sf[2][4][2];
#pragma unroll
        for (int d = 0; d < 2; ++d)
#pragma unroll
            for (int pt = 0; pt < 4; ++pt)
#pragma unroll
                for (int ks = 0; ks < 2; ++ks) sf[d][pt][ks] = *(const bf16x8*)(STS + (size_t)((ch * 8 + hh) * 2 + d) * 4096 + (16 * pt + lr) * 64 + 32 * ks + 8 * lq);
        __syncthreads();
        {
            const int ait = wave >> 1, i = 16 * ait + lr;
#pragma unroll
            for (int j2 = 0; j2 < 2; ++j2) { const int jt = 2 * (wave & 1) + j2, j0 = 16 * jt + 4 * lq; pg8::f32x4 cb = {0.f, 0.f, 0.f, 0.f};
                cb = MFMA16(ldsfrag(BM, 16 * jt + lr, 0, lq), ldsfrag(CM, 16 * ait + lr, 0, lq), cb); cb = MFMA16(ldsfrag(BM, 16 * jt + lr, 1, lq), ldsfrag(CM, 16 * ait + lr, 1, lq), cb);
#pragma unroll
                for (int h4 = 0; h4 < 4; ++h4) { const float sfi = SC[h4 * 64 + i], sbi = SC[(4 + h4) * 64 + i]; float p[4];
#pragma unroll
                    for (int r = 0; r < 4; ++r) { const int j = j0 + r; float w = 0.f;
                        if (j <= i) w += __expf(sfi - SC[h4 * 64 + j]) * DL[h4 * 64 + j];
                        if (j >= i) w += __expf(sbi - SC[(4 + h4) * 64 + j]) * DL[(4 + h4) * 64 + j];
                        p[r] = cb[r] * w; }
                    v2u o; o.x = pk2(p[0], p[1]); o.y = pk2(p[2], p[3]); *(LAS v2u*)(Mi + (h4 * 64 + i) * RS + j0 * 2) = o; } }
        }
        __syncthreads();
        LAS unsigned char* XTh = XT + (hl * 64) * RS; LAS unsigned char* Mh = Mi + (hl * 64) * RS;
        float rs2[2]; float yv[2][4][4];
#pragma unroll
        for (int i2 = 0; i2 < 2; ++i2) { const int it = 2 * ih + i2, i = 16 * it + lr; const size_t m = m0 + i;
            pg8::f32x4 ai[4], af[4], ab[4];
#pragma unroll
            for (int pt = 0; pt < 4; ++pt) { ai[pt] = (pg8::f32x4){0.f, 0.f, 0.f, 0.f}; af[pt] = ai[pt]; ab[pt] = ai[pt]; }
#pragma unroll
            for (int ks = 0; ks < 2; ++ks) { const bf16x8 bm = ldsfrag(Mh, i, ks, lq), bc = ldsfrag(CM, i, ks, lq);
#pragma unroll
                for (int pt = 0; pt < 4; ++pt) { ai[pt] = MFMA16(ldsfrag(XTh, 16 * pt + lr, ks, lq), bm, ai[pt]); af[pt] = MFMA16(sf[0][pt][ks], bc, af[pt]); ab[pt] = MFMA16(sf[1][pt][ks], bc, ab[pt]); } }
            const float ef = __expf(SC[hl * 64 + i]), eb = __expf(SC[(4 + hl) * 64 + i]), ds = d_skip[hh]; float ss = 0.f;
#pragma unroll
            for (int pt = 0; pt < 4; ++pt) { const int p0 = 16 * pt + 4 * lq; const v2u z = *(const v2u*)(PROJ + m * LDP + PZ + hh * 64 + p0);
                const float zz[4] = {bflo(z.x), bfhi(z.x), bflo(z.y), bfhi(z.y)};
#pragma unroll
                for (int r = 0; r < 4; ++r) { const float xs = bf1(*(const LAS unsigned short*)(XTh + (p0 + r) * RS + i * 2));
                    const float y = (ai[pt][r] + ef * af[pt][r] + eb * ab[pt][r] + ds * xs) * silu(zz[r]); yv[i2][pt][r] = y; ss += y * y; } }
            ss += bperm(ss, lane ^ 16); ss += bperm(ss, lane ^ 32);
            if (lq == 0) RED[wave * 32 + i2 * 16 + lr] = ss;
        }
        __syncthreads();
#pragma unroll
        for (int i2 = 0; i2 < 2; ++i2) { float t = 0.f;
#pragma unroll
            for (int h4 = 0; h4 < 4; ++h4) t += RED[(2 * h4 + ih) * 32 + i2 * 16 + lr];
            rs2[i2] = rsqrtf(t * (1.f / 256.f) + EPS); }
#pragma unroll
        for (int i2 = 0; i2 < 2; ++i2) { const size_t m = m0 + 16 * (2 * ih + i2) + lr;
#pragma unroll
            for (int pt = 0; pt < 4; ++pt) { const int col = 256 * g + 64 * hl + 16 * pt + 4 * lq; const f32x4 gn = *(const f32x4*)(ssd_norm + col);
                v2u o; o.x = pk2(yv[i2][pt][0] * rs2[i2] * gn.x, yv[i2][pt][1] * rs2[i2] * gn.y); o.y = pk2(yv[i2][pt][2] * rs2[i2] * gn.z, yv[i2][pt][3] * rs2[i2] * gn.w);
                *(v2u*)(OMIX + m * 1024 + 512 + col) = o; } }
        __syncthreads();
    }
}

__global__ void __launch_bounds__(NT, 2) fwd_kernel(Args args) {
    extern __shared__ __attribute__((aligned(16))) unsigned char lds_raw[];
    LAS unsigned char* lds = (LAS unsigned char*)lds_raw;
    const int bl = blockIdx.x; constexpr int NGW = GRID * NW;
    { volatile LAS unsigned* misc = (volatile LAS unsigned*)(lds + 131072 + 320); if (threadIdx.x < 32) misc[threadIdx.x] = 0u; }
    __syncthreads();
    const XcdBarrier gbar = xcd_barrier_post((unsigned*)(args.ws) + 4096, (volatile LAS unsigned*)(lds + 131072 + 320) + 8);
#define PHASE_IDS int tid_o_ = threadIdx.x; asm volatile("" : "+v"(tid_o_)); const int tid = tid_o_, lane = tid & 63, wave = __builtin_amdgcn_readfirstlane(tid >> 6), gw = bl * NW + wave; (void)lane; (void)wave; (void)gw;
    unsigned char* ws = args.ws;
    const float* x = args.in[0]; const float* cvec = args.in[1]; const float* ctx = args.in[2]; const float* c_ctx = args.in[3];
    const float* w_mod = args.in[4]; const float* b_mod = args.in[5];
    const float* g_mix_pre = args.in[6]; const float* g_mix_post = args.in[7]; const float* g_ffn_pre = args.in[8]; const float* g_ffn_post = args.in[9];
    const float* w_in = args.in[10]; const float* conv_w = args.in[11]; const float* conv_b = args.in[12];
    const float* wg_f = args.in[13]; const float* bg_f = args.in[14]; const float* wg_b = args.in[15]; const float* bg_b = args.in[16];
    const float* gla_norm = args.in[17]; const float* a_log_f = args.in[18]; const float* a_log_b = args.in[19];
    const float* dt_bias_f = args.in[20]; const float* dt_bias_b = args.in[21]; const float* d_skip = args.in[22]; const float* ssd_norm = args.in[23];
    const float* w_out = args.in[24]; const float* w_gate = args.in[25]; const float* w_up = args.in[26]; const float* w_down = args.in[27];
    float* out = args.out;
    float* MODP = (float*)(ws + WS_MODP); float* MODF = (float*)(ws + WS_MODF);
    bf16* Win_t = (bf16*)(ws + WS_WIN); bf16* Wout_t = (bf16*)(ws + WS_WOUT);
    bf16* Wgu_t = (bf16*)(ws + WS_G); bf16* Wdn_t = (bf16*)(ws + WS_G + 12 * MiB);
    bf16* H = (bf16*)out;
    bf16* R1 = (bf16*)(ws + WS_R1);
    bf16* PROJ = (bf16*)(ws + WS_PROJ);
    float* Yf = (float*)(ws + WS_PROJ);
    bf16* ACT = (bf16*)(ws + WS_PROJ);
    float* GT = (float*)(ws + WS_G);
    float* DTt = (float*)(ws + WS_SMALL + SM_DT);
    float* At = (float*)(ws + WS_SMALL + SM_A);
    float* DECG = (float*)(ws + WS_SMALL + SM_DECG);
    float* DECS = (float*)(ws + WS_SMALL + SM_DECS);
    bf16* STG = (bf16*)(ws + WS_ST);
    bf16* STS = (bf16*)(ws + WS_ST + 34 * MiB);
    float* Ff = (float*)(ws + WS_ST);

#ifndef NO_P0
    {
        PHASE_IDS
        for (int i = tid; i < 5 * 1024; i += NT) { const int r = i >> 10, k = i & 1023; const float v = (r < 4) ? cvec[r * 1024 + k] : c_ctx[k];
            ((LAS float*)(lds + 16384 * r + 12288))[k] = silu(v); }
        __syncthreads();
        LAS float* scr = (LAS float*)(lds + wave * 16384);
        constexpr int I_IN = 16 * 90, I_OUT = 16 * 32, I_MOD = 96 * 8;
        for (int it = gw; it < I_IN + I_OUT + I_MOD; it += NGW) {
            int r = it;
            if (r < I_IN) { const int kb = r / 90, nb = r % 90; const int dst = (nb < 48) ? 32 * nb : (nb == 48) ? 2816 : (nb < 89) ? 32 * (nb - 1) : 2848;
                transpose_item(w_in, 1024, DIN, Win_t, dst, 64 * kb, 32 * nb, scr, lane); continue; }
            r -= I_IN;
            if (r < I_OUT) { const int kb = r / 32, nb = r % 32; transpose_item(w_out, 1024, 1024, Wout_t, 32 * nb, 64 * kb, 32 * nb, scr, lane); continue; }
            r -= I_OUT;
            { const int ng = r % 96, ks = r / 96; const int n = 64 * ng + lane; float a0 = 0.f, a1 = 0.f, a2 = 0.f, a3 = 0.f, a4 = 0.f;
#pragma unroll 32
              for (int k = 128 * ks; k < 128 * ks + 128; ++k) { const float w = w_mod[(size_t)k * 6144 + n];
                  a0 += ((LAS float*)(lds + 16384 * 0 + 12288))[k] * w; a1 += ((LAS float*)(lds + 16384 * 1 + 12288))[k] * w; a2 += ((LAS float*)(lds + 16384 * 2 + 12288))[k] * w;
                  a3 += ((LAS float*)(lds + 16384 * 3 + 12288))[k] * w; a4 += ((LAS float*)(lds + 16384 * 4 + 12288))[k] * w; }
              float* p = MODP + (size_t)(ks * 5) * 6144 + n; p[0] = a0; p[6144] = a1; p[2 * 6144] = a2; p[3 * 6144] = a3; p[4 * 6144] = a4; }
        }
    }
#endif
    xcd_barrier(gbar);

#ifndef NO_P1
    {
        PHASE_IDS
        LAS float* T = (LAS float*)lds;
        const int b = bl >> 6;
        for (int i = tid; i < 4096; i += NT) { const int which = i >> 10, d = i & 1023, r = (which < 2) ? b : 4, e = (which & 1) * 1024 + d;
            float s = b_mod[e];
#pragma unroll
            for (int ks = 0; ks < 8; ++ks) s += MODP[(size_t)(ks * 5 + r) * 6144 + e];
            T[i] = s; }
        if (bl < 60) { const int e5 = bl * NT + tid, r = e5 / 6144, e = e5 % 6144; float s = b_mod[e];
#pragma unroll
            for (int ks = 0; ks < 8; ++ks) s += MODP[(size_t)(ks * 5 + r) * 6144 + e];
            MODF[e5] = s; }
        __syncthreads();
        _Pragma("unroll 1") for (int grp = 0; grp < 3; ++grp) {
            if (grp == 2 && wave >= 4) break;
            const int nr = (grp < 2) ? 4 : 1, toff = (grp < 2) ? 0 : 2048;
            f32x4 v[4][4];
#pragma unroll
            for (int q = 0; q < 4; ++q) { if (q < nr) { const float* src = (grp < 2) ? x + (size_t)(64 * bl + 8 * wave + 4 * grp + q) * D : ctx + (size_t)(4 * bl + wave) * D;
#pragma unroll
                for (int j = 0; j < 4; ++j) v[q][j] = *(const f32x4*)(src + 4 * (lane + 64 * j)); } }
#pragma unroll
            for (int q = 0; q < 4; ++q) { if (q < nr) { const int m = (grp < 2) ? 64 * bl + 8 * wave + 4 * grp + q : MLAT + 4 * bl + wave; float ss = 0.f;
#pragma unroll
                for (int j = 0; j < 4; ++j) ss += (v[q][j].x * v[q][j].x + v[q][j].y * v[q][j].y) + (v[q][j].z * v[q][j].z + v[q][j].w * v[q][j].w);
#pragma unroll
                for (int o = 1; o < 64; o <<= 1) ss += shx(ss, o, lane);
                const float rstd = rsqrtf(ss * (1.f / D) + EPS);
#pragma unroll
                for (int j = 0; j < 4; ++j) { const int d0 = 4 * (lane + 64 * j); const f32x4 g = *(const f32x4*)(g_mix_pre + d0);
                    const f32x4 sh = *(LAS f32x4*)(T + toff + d0), sc = *(LAS f32x4*)(T + toff + 1024 + d0);
                    const f32x4 h = (v[q][j] * rstd * g) * (sc + 1.0f) + sh;
                    v2u w; w.x = pk2(h.x, h.y); w.y = pk2(h.z, h.w); *(v2u*)(H + (size_t)m * D + d0) = w; } } }
        }
    }
#endif
    xcd_barrier(gbar);

#ifndef NO_P2
    {
        pg8::Gemm g{H, Win_t, MALL, 2816, 1024}; pg8::StaticOrder S; S.init(MALL, 2816, GRID, bl);
        pg8::EpiProj E{PROJ};
        pg8::gemm_phase<pg8::EpiProj, pg8::StaticOrder, true, true>(lds, g, S, E);
    }
#endif
    xcd_barrier(gbar);

#ifndef NO_P3
    {
        PHASE_IDS
        bf16* XBC = R1;
        for (int it = bl; it < 816 + NCH; it += GRID) {
            PHASE_IDS
            if (it < 816) {
                const int ch = it / 3, third = it % 3, ch0 = third * 256 + 8 * (tid & 31), sub = tid >> 5;
                f32x4 cb0 = *(const f32x4*)(conv_b + ch0), cb1 = *(const f32x4*)(conv_b + ch0 + 4);
                for (int q = 0; q < 4; ++q) {
                    const int t = sub + 16 * q; float acc[8] = {cb0.x, cb0.y, cb0.z, cb0.w, cb1.x, cb1.y, cb1.z, cb1.w};
                    const bool lat = ch < NCHL; const int bb = lat ? (ch >> 6) : ((ch - 256) >> 2), cc = lat ? (ch & 63) : ((ch - 256) & 3);
#pragma unroll
                    for (int dr = -1; dr <= 1; ++dr) {
                        if (!lat && dr != 0) continue;
                        if (lat && (cc + dr < 0 || cc + dr > 63)) continue;
#pragma unroll
                        for (int dc = -1; dc <= 1; ++dc) {
                            int mrow;
                            if (lat) { const int tt = t + dc; if (tt < 0 || tt > 63) continue; mrow = bb * SEQ + (cc + dr) * 64 + tt; }
                            else { const int tt = cc * 64 + t + dc; if (tt < 0 || tt > 255) continue; mrow = MLAT + bb * CTX + tt; }
                            const v4u xv = *(const v4u*)(PROJ + (size_t)mrow * LDP + PX + ch0);
                            const float* wp = conv_w + ((dr + 1) * 3 + (dc + 1)) * 768 + ch0; const f32x4 w0 = *(const f32x4*)wp, w1 = *(const f32x4*)(wp + 4);
                            acc[0] += w0.x * bflo(xv.x); acc[1] += w0.y * bfhi(xv.x); acc[2] += w0.z * bflo(xv.y); acc[3] += w0.w * bfhi(xv.y);
                            acc[4] += w1.x * bflo(xv.z); acc[5] += w1.y * bfhi(xv.z); acc[6] += w1.z * bflo(xv.w); acc[7] += w1.w * bfhi(xv.w);
                        }
                    }
                    v4u o; o.x = pk2(silu(acc[0]), silu(acc[1])); o.y = pk2(silu(acc[2]), silu(acc[3])); o.z = pk2(silu(acc[4]), silu(acc[5])); o.w = pk2(silu(acc[6]), silu(acc[7]));
                    *(v4u*)(XBC + (size_t)(64 * ch + t) * 768 + ch0) = o;
                }
            } else {
                const int ch = it - 816; LAS float* PART = (LAS float*)lds; LAS float* LR = (LAS float*)(lds + 98304); LAS float* DTR = (LAS float*)(lds + 106496);
                {
                    const int lr_ = lane & 15, lq_ = lane >> 4; pg8::f32x4 acc[4][3];
#pragma unroll
                    for (int rt = 0; rt < 4; ++rt)
#pragma unroll
                        for (int ct = 0; ct < 3; ++ct) acc[rt][ct] = (pg8::f32x4){0.f, 0.f, 0.f, 0.f};
                    const bf16* hp = H + (size_t)(64 * ch + lr_) * D + 128 * wave + 8 * lq_; const bf16* wp = Win_t + (size_t)(2816 + lr_) * D + 128 * wave + 8 * lq_;
#pragma unroll
                    for (int ks = 0; ks < 4; ++ks) { bf16x8 af[4], bfr[3];
#pragma unroll
                        for (int rt = 0; rt < 4; ++rt) af[rt] = *(const bf16x8*)(hp + (size_t)(16 * rt) * D + 32 * ks);
#pragma unroll
                        for (int ct = 0; ct < 3; ++ct) bfr[ct] = *(const bf16x8*)(wp + (size_t)(16 * ct) * D + 32 * ks);
#pragma unroll
                        for (int rt = 0; rt < 4; ++rt)
#pragma unroll
                            for (int ct = 0; ct < 3; ++ct) acc[rt][ct] = MFMA16(af[rt], bfr[ct], acc[rt][ct]); }
#pragma unroll
                    for (int rt = 0; rt < 4; ++rt)
#pragma unroll
                        for (int ct = 0; ct < 3; ++ct)
#pragma unroll
                            for (int r = 0; r < 4; ++r) PART[(wave * 64 + 16 * rt + 4 * lq_ + r) * 48 + 16 * ct + lr_] = acc[rt][ct][r];
                }
                __syncthreads();
#pragma unroll
                for (int i = 0; i < 6; ++i) { const int idx = tid + NT * i, tok = idx / 48, col = idx % 48; float v = 0.f;
#pragma unroll
                    for (int w8 = 0; w8 < 8; ++w8) v += PART[(w8 * 64 + tok) * 48 + col];
                    if (col < 32) LR[tok * 32 + col] = v; else DTR[tok * 16 + col - 32] = v; }
                __syncthreads();
                const int d = tid >> 8, col = tid & 255; const float* wg = d ? wg_b : wg_f; float wr[16];
#pragma unroll
                for (int r = 0; r < 16; ++r) wr[r] = wg[r * 256 + col];
                const float bg = (d ? bg_b : bg_f)[col]; float* Gd = GT + (size_t)d * MALL * 256;
                for (int t = 0; t < 64; ++t) { float dot = bg;
#pragma unroll
                    for (int r = 0; r < 16; ++r) dot += LR[t * 32 + 16 * d + r] * wr[r];
                    Gd[(size_t)(64 * ch + t) * 256 + col] = logsigmoid(dot) * (1.0f / 16.0f); }
#pragma unroll
                for (int i = 0; i < 2; ++i) { const int idx = tid + NT * i, tok = idx >> 4, dh = idx & 15, dd = dh >> 3, hh = dh & 7; const size_t m = 64 * ch + tok;
                    const float raw = DTR[tok * 16 + dh]; const float dt = softplus(raw + (dd ? dt_bias_b : dt_bias_f)[hh]);
                    DTt[((size_t)dd * MALL + m) * 8 + hh] = dt; At[((size_t)dd * MALL + m) * 8 + hh] = -dt * __expf((dd ? a_log_b : a_log_f)[hh]); }
                __syncthreads();
            }
        }
    }
#endif
    xcd_barrier(gbar);

    bf16* OMIX = (bf16*)out;
    {
        const bf16* XBC = R1;
        _Pragma("unroll 1") for (int u = bl; u < 4 * NCH + 2 * NCH; u += GRID) {
            if (u < 4 * NCH) gla_unit<0>(lds, u >> 2, u & 3, PROJ, GT, STG, DECG, OMIX, gla_norm);
            else { const int v = u - 4 * NCH; ssd_unit<0>(lds, v >> 1, v & 1, PROJ, XBC, At, DTt, STS, DECS, OMIX, d_skip, ssd_norm); }
        }
    }
    xcd_barrier(gbar);
    {
        PHASE_IDS
        const int gt = bl * NT + tid;
        if (gt < 65536) {
            const int chain = gt >> 11, b = chain >> 3, h = (chain >> 1) & 3, d = chain & 1, e = 4 * (gt & 2047);
            float s0 = 0.f, s1 = 0.f, s2 = 0.f, s3 = 0.f;
            _Pragma("unroll 1") for (int st = 0; st < 68; st += 17) {
                v2u loc[17]; f32x4 dec[17]; bf16* ad[17];
#pragma unroll
                for (int u = 0; u < 17; ++u) { const int ch = chain_chunk(b, d, st + u); ad[u] = STG + (size_t)((ch * 4 + h) * 2 + d) * 8192 + e; loc[u] = *(const v2u*)ad[u];
                    dec[u] = *(const f32x4*)(DECG + (size_t)(ch * 2 + d) * 256 + h * 64 + (e & 63)); }
#pragma unroll
                for (int u = 0; u < 17; ++u) { v2u o; o.x = pk2(s0, s1); o.y = pk2(s2, s3); *(v2u*)ad[u] = o;
                    s0 = s0 * dec[u].x + bflo(loc[u].x); s1 = s1 * dec[u].y + bfhi(loc[u].x); s2 = s2 * dec[u].z + bflo(loc[u].y); s3 = s3 * dec[u].w + bfhi(loc[u].y); }
            }
        } else {
            const int g2 = gt - 65536, chain = g2 >> 10, b = chain >> 4, hh = (chain >> 1) & 7, d = chain & 1, e = 4 * (g2 & 1023);
            float s0 = 0.f, s1 = 0.f, s2 = 0.f, s3 = 0.f;
            _Pragma("unroll 1") for (int st = 0; st < 68; st += 17) {
                v2u loc[17]; float dec[17]; bf16* ad[17];
#pragma unroll
                for (int u = 0; u < 17; ++u) { const int ch = chain_chunk(b, d, st + u); ad[u] = STS + (size_t)((ch * 8 + hh) * 2 + d) * 4096 + e; loc[u] = *(const v2u*)ad[u];
                    dec[u] = DECS[(size_t)(ch * 2 + d) * 8 + hh]; }
#pragma unroll
                for (int u = 0; u < 17; ++u) { v2u o; o.x = pk2(s0, s1); o.y = pk2(s2, s3); *(v2u*)ad[u] = o;
                    s0 = s0 * dec[u] + bflo(loc[u].x); s1 = s1 * dec[u] + bfhi(loc[u].x); s2 = s2 * dec[u] + bflo(loc[u].y); s3 = s3 * dec[u] + bfhi(loc[u].y); }
            }
        }
    }
    xcd_barrier(gbar);
    {
        const bf16* XBC = R1;
        _Pragma("unroll 1") for (int u = bl; u < 4 * NCHL + 2 * NCHL; u += GRID) {
            if (u < 4 * NCHL) gla_unit<1>(lds, u >> 2, u & 3, PROJ, GT, STG, DECG, OMIX, gla_norm);
            else { const int v = u - 4 * NCHL; ssd_unit<1>(lds, v >> 1, v & 1, PROJ, XBC, At, DTt, STS, DECS, OMIX, d_skip, ssd_norm); }
        }
    }
    xcd_barrier(gbar);

#ifndef NO_P7
    {
        pg8::Gemm g{OMIX, Wout_t, MLAT, 1024, 1024}; pg8::StaticOrder S; S.init(MLAT, 1024, GRID, bl);
        pg8::EpiF32 E{Yf};
        pg8::gemm_phase<pg8::EpiF32, pg8::StaticOrder, true, true>(lds, g, S, E);
    }
#endif
    xcd_barrier(gbar);

#ifndef NO_P7b
    {
        PHASE_IDS
        LAS float* T = (LAS float*)lds;
        const int b = bl >> 6; bf16* H2 = R1;
        for (int i = tid; i < 3072; i += NT) T[i] = MODF[(size_t)b * 6144 + 2048 + i];
        __syncthreads();
        _Pragma("unroll 1") for (int grp = 0; grp < 4; ++grp) {
            f32x4 v[2][4], xv[2][4];
#pragma unroll
            for (int q = 0; q < 2; ++q) { const int m = 64 * bl + 8 * wave + 2 * grp + q;
#pragma unroll
                for (int j = 0; j < 4; ++j) { v[q][j] = *(const f32x4*)(Yf + (size_t)m * D + 4 * (lane + 64 * j)); xv[q][j] = *(const f32x4*)(x + (size_t)m * D + 4 * (lane + 64 * j)); } }
#pragma unroll
            for (int q = 0; q < 2; ++q) { const int m = 64 * bl + 8 * wave + 2 * grp + q; float ss = 0.f;
#pragma unroll
                for (int j = 0; j < 4; ++j) ss += (v[q][j].x * v[q][j].x + v[q][j].y * v[q][j].y) + (v[q][j].z * v[q][j].z + v[q][j].w * v[q][j].w);
#pragma unroll
                for (int o = 1; o < 64; o <<= 1) ss += shx(ss, o, lane);
                const float rstd = rsqrtf(ss * (1.f / D) + EPS); float s2 = 0.f;
#pragma unroll
                for (int j = 0; j < 4; ++j) { const int d0 = 4 * (lane + 64 * j); const f32x4 g = *(const f32x4*)(g_mix_post + d0), gt = *(LAS f32x4*)(T + d0);
                    v[q][j] = xv[q][j] + gt * (v[q][j] * rstd * g); *(f32x4*)(out + (size_t)m * D + d0) = v[q][j];
                    s2 += (v[q][j].x * v[q][j].x + v[q][j].y * v[q][j].y) + (v[q][j].z * v[q][j].z + v[q][j].w * v[q][j].w); }
#pragma unroll
                for (int o = 1; o < 64; o <<= 1) s2 += shx(s2, o, lane);
                const float rstd2 = rsqrtf(s2 * (1.f / D) + EPS);
#pragma unroll
                for (int j = 0; j < 4; ++j) { const int d0 = 4 * (lane + 64 * j); const f32x4 g = *(const f32x4*)(g_ffn_pre + d0), sh = *(LAS f32x4*)(T + 1024 + d0), sc = *(LAS f32x4*)(T + 2048 + d0);
                    const f32x4 h = (v[q][j] * rstd2 * g) * (sc + 1.0f) + sh; v2u w; w.x = pk2(h.x, h.y); w.y = pk2(h.z, h.w); *(v2u*)(H2 + (size_t)m * D + d0) = w; } }
        }
        LAS float* scr = (LAS float*)(lds + wave * 16384);
        constexpr int I_G = 16 * 88, I_D = 44 * 32;
        for (int it = gw; it < 2 * I_G + I_D; it += NGW) {
            int r = it;
            if (r < 2 * I_G) { const int up = r >= I_G; if (up) r -= I_G; const int kb = r / 88, nb = r % 88;
                transpose_item(up ? w_up : w_gate, 1024, DFF, Wgu_t, 256 * (nb >> 2) + 32 * (nb & 3) + (up ? 128 : 0), 64 * kb, 32 * nb, scr, lane); continue; }
            r -= 2 * I_G;
            { const int kb = r / 32, nb = r % 32; transpose_item(w_down, DFF, 1024, Wdn_t, 32 * nb, 64 * kb, 32 * nb, scr, lane); }
        }
    }
#endif
    xcd_barrier(gbar);

#ifndef NO_P8
    {
        pg8::Gemm g{R1, Wgu_t, MLAT, 2 * DFF, 1024}; pg8::StaticOrder S; S.init(MLAT, 2 * DFF, GRID, bl);
        pg8::EpiSwiglu E{ACT};
        pg8::gemm_phase<pg8::EpiSwiglu, pg8::StaticOrder, true, true>(lds, g, S, E);
    }
#endif
    xcd_barrier(gbar);

#ifndef NO_P9
    {
        pg8::Gemm g{ACT, Wdn_t, MLAT, 1024, DFF}; pg8::StaticOrder S; S.init(MLAT, 1024, GRID, bl);
        pg8::EpiF32 E{Ff};
        pg8::gemm_phase<pg8::EpiF32, pg8::StaticOrder, true, true>(lds, g, S, E);
    }
#endif
    xcd_barrier(gbar);

#ifndef NO_P9b
    {
        PHASE_IDS
        LAS float* T = (LAS float*)lds; const int b = bl >> 6;
        for (int i = tid; i < 1024; i += NT) T[i] = MODF[(size_t)b * 6144 + 5 * 1024 + i];
        __syncthreads();
        _Pragma("unroll 1") for (int grp = 0; grp < 4; ++grp) {
            f32x4 v[2][4], xv[2][4];
#pragma unroll
            for (int q = 0; q < 2; ++q) { const int m = 64 * bl + 8 * wave + 2 * grp + q;
#pragma unroll
                for (int j = 0; j < 4; ++j) { v[q][j] = *(const f32x4*)(Ff + (size_t)m * D + 4 * (lane + 64 * j)); xv[q][j] = *(const f32x4*)(out + (size_t)m * D + 4 * (lane + 64 * j)); } }
#pragma unroll
            for (int q = 0; q < 2; ++q) { const int m = 64 * bl + 8 * wave + 2 * grp + q; float ss = 0.f;
#pragma unroll
                for (int j = 0; j < 4; ++j) ss += (v[q][j].x * v[q][j].x + v[q][j].y * v[q][j].y) + (v[q][j].z * v[q][j].z + v[q][j].w * v[q][j].w);
#pragma unroll
                for (int o = 1; o < 64; o <<= 1) ss += shx(ss, o, lane);
                const float rstd = rsqrtf(ss * (1.f / D) + EPS);
#pragma unroll
                for (int j = 0; j < 4; ++j) { const int d0 = 4 * (lane + 64 * j); const f32x4 g = *(const f32x4*)(g_ffn_post + d0), gt = *(LAS f32x4*)(T + d0);
                    *(f32x4*)(out + (size_t)m * D + d0) = xv[q][j] + gt * (v[q][j] * rstd * g); } }
        }
    }
#endif
}

extern "C" void kernel_launch(void* const* d_in, const int* in_sizes, int n_in, void* d_out, int out_size, void* d_ws, size_t ws_size, hipStream_t stream) {
    static int ready = 0;
    if (ready == 0) {
        if (n_in != 28 || out_size != MLAT * D || ws_size < WS_END) { fprintf(stderr, "kernel_launch: unexpected shapes (n_in %d out %d ws %zu)\n", n_in, out_size, ws_size); ready = -1; return; }
        if (hipFuncSetAttribute((const void*)fwd_kernel, hipFuncAttributeMaxDynamicSharedMemorySize, LDS_BYTES) != hipSuccess) { fprintf(stderr, "kernel_launch: hipFuncSetAttribute failed\n"); ready = -1; return; }
        int per_cu = 0, dev = 0, cus = 0; hipGetDevice(&dev); hipDeviceGetAttribute(&cus, hipDeviceAttributeMultiprocessorCount, dev);
        hipOccupancyMaxActiveBlocksPerMultiprocessor(&per_cu, (const void*)fwd_kernel, NT, LDS_BYTES);
        if (per_cu < 1 || cus < GRID) { fprintf(stderr, "kernel_launch: occupancy %d blocks/CU on %d CUs: cannot co-reside %d blocks\n", per_cu, cus, GRID); ready = -1; return; }
        (void)hipGetLastError();
        ready = 1;
    }
    if (ready < 0) return;
    Args a{};
    for (int i = 0; i < 28; ++i) a.in[i] = (const float*)d_in[i];
    a.out = (float*)d_out; a.ws = (unsigned char*)d_ws;
    if (hipMemsetAsync(d_ws, 0, 1 << 20, stream) != hipSuccess) { fprintf(stderr, "kernel_launch: memset failed\n"); return; }
    hipLaunchKernelGGL(fwd_kernel, dim3(GRID), dim3(NT), LDS_BYTES, stream, a);
    const hipError_t e = hipPeekAtLastError();
    if (e != hipSuccess) fprintf(stderr, "kernel_launch: launch failed: %s\n", hipGetErrorString(e));
}
```

```cpp
#include <hip/hip_runtime.h>
#include <hip/hip_cooperative_groups.h>
#include <cstdio>
#include <cstdint>
#ifndef PROBE_LO
#define PROBE_LO -1
#define PROBE_HI -1
#endif
namespace cg = cooperative_groups;
namespace pg8 {
#define PG8_LAS __attribute__((address_space(3)))
typedef unsigned short bf16_t;
typedef short bf16x8 __attribute__((ext_vector_type(8)));
typedef float f32x4 __attribute__((ext_vector_type(4)));
typedef unsigned u32x4 __attribute__((ext_vector_type(4)));
constexpr int BM = 256, BK = 64, HALF = 128, HTB = HALF * BK * 2  , STAGE_BYTES = 8 * HTB, NXCD = 8, WGM = 8;

__host__ __device__ __forceinline__ int lds_byte(int r, int c) { const int st = (r >> 4) * 2 + (c >> 5), rr = r & 15, cc = c & 31, ob = rr * 64 + cc * 2; return st * 1024 + (ob ^ (((ob >> 9) & 1) << 5)); }
__host__ __device__ __forceinline__ void stage_rc(int b, int& R, int& C) { const int st = b / 1024, sb = b % 1024, swz = sb ^ (((sb >> 9) & 1) << 5); R = (st >> 1) * 16 + swz / 64; C = (st & 1) * 32 + (swz % 64) / 2; }
__host__ __device__ __forceinline__ int perm32(int rho) { const int n = rho >> 4, i = rho & 15; return 8 * (i >> 2) + 4 * n + (i & 3); }

struct Unit { int pm, pn; };
struct Gemm { const bf16_t* A; const bf16_t* Bt; int M, N, K; };

struct StaticOrder {
    int nM, nN, nwg, G, c;
    __host__ __device__ void init(int M, int N, int G_, int c_) { nM = M / BM; nN = N / BM; nwg = nM * nN; G = G_; c = c_; }
    __host__ __device__ bool next(int i, Unit& u) const {
        const long L = (long)i * G + c; if (L >= nwg) return false;
        int wgid = (int)L; { const int q = nwg / NXCD, r = nwg % NXCD, xcd = wgid % NXCD, off = wgid / NXCD; wgid = (xcd < r ? xcd * (q + 1) : r * (q + 1) + (xcd - r) * q) + off; }
        const int nig = WGM * nN, gid = wgid / nig, fm = gid * WGM, gsz = (nM - fm) < WGM ? (nM - fm) : WGM;
        u.pm = fm + ((wgid % nig) % gsz); u.pn = (wgid % nig) / gsz; return true;
    }
    __device__ __forceinline__ void a_ready(const Unit&) const {}
    __device__ __forceinline__ void done(const Unit&) const {}
};

__device__ __forceinline__ unsigned cvt_pk_bf16(float lo, float hi) { unsigned r; asm volatile("v_cvt_pk_bf16_f32 %0, %1, %2" : "=v"(r) : "v"(lo), "v"(hi)); return r; }
typedef float f32x2 __attribute__((ext_vector_type(2)));
__device__ __forceinline__ float silu_f(float x) { return x * __builtin_amdgcn_rcpf(1.0f + __expf(-x)); }
struct EpiProj {
    static constexpr bool PERM = true, AFTER_DRAIN = false;
    bf16_t* O;
    __device__ __forceinline__ void operator()(const f32x4 (&acc)[2][2][4][2], const Unit& u, int wr, int wc, int fr, int fq) const {
        const int row0 = u.pm * BM + wr * 64 + fr;
#pragma unroll
        for (int bj = 0; bj < 2; ++bj) {
            const int col0 = u.pn * BM + bj * HALF + wc * 32 + 8 * fq;
            if (col0 >= 2880) continue;
            const float sc = (col0 < 256) ? 0.125f : 1.0f;
#pragma unroll
            for (int ai = 0; ai < 2; ++ai)
#pragma unroll
                for (int m = 0; m < 4; ++m) {
                    const f32x4 v0 = acc[ai][bj][m][0] * sc, v1 = acc[ai][bj][m][1] * sc;
                    u32x4 w; w.x = cvt_pk_bf16(v0[0], v0[1]); w.y = cvt_pk_bf16(v0[2], v0[3]); w.z = cvt_pk_bf16(v1[0], v1[1]); w.w = cvt_pk_bf16(v1[2], v1[3]);
                    *(u32x4*)(O + (size_t)(row0 + ai * HALF + m * 16) * 2880 + col0) = w;
                }
        }
    }
};
struct EpiF32 {
    static constexpr bool PERM = false, AFTER_DRAIN = false;
    float* O;
    __device__ __forceinline__ void operator()(const f32x4 (&acc)[2][2][4][2], const Unit& u, int wr, int wc, int fr, int fq) const {
        const int row0 = u.pm * BM + wr * 64 + fr, col0 = u.pn * BM + wc * 32 + 4 * fq;
#pragma unroll
        for (int ai = 0; ai < 2; ++ai)
#pragma unroll
            for (int m = 0; m < 4; ++m) {
                float* rowp = O + (size_t)(row0 + ai * HALF + m * 16) * 1024 + col0;
#pragma unroll
                for (int bj = 0; bj < 2; ++bj)
#pragma unroll
                    for (int n = 0; n < 2; ++n) *(f32x4*)(rowp + bj * HALF + n * 16) = acc[ai][bj][m][n];
            }
    }
};
struct EpiSwiglu {
    static constexpr bool PERM = true, AFTER_DRAIN = false;
    bf16_t* O;
    __device__ __forceinline__ void operator()(const f32x4 (&acc)[2][2][4][2], const Unit& u, int wr, int wc, int fr, int fq) const {
        const int row0 = u.pm * BM + wr * 64 + fr, col0 = u.pn * HALF + wc * 32 + 8 * fq;
#pragma unroll
        for (int ai = 0; ai < 2; ++ai)
#pragma unroll
            for (int m = 0; m < 4; ++m) {
                float r[8];
#pragma unroll
                for (int n = 0; n < 2; ++n)
#pragma unroll
                    for (int j = 0; j < 4; ++j) r[n * 4 + j] = silu_f(acc[ai][0][m][n][j]) * acc[ai][1][m][n][j];
                u32x4 w; w.x = cvt_pk_bf16(r[0], r[1]); w.y = cvt_pk_bf16(r[2], r[3]); w.z = cvt_pk_bf16(r[4], r[5]); w.w = cvt_pk_bf16(r[6], r[7]);
                *(u32x4*)(O + (size_t)(row0 + ai * HALF + m * 16) * 2816 + col0) = w;
            }
    }
};

template <class Epi, class Sched, bool ALIGN_EPI = false, bool SP2 = false>
__device__ __forceinline__ void gemm_phase(PG8_LAS unsigned char* lds, const Gemm g, const Sched& S, const Epi& E) {
    int tid_l_ = threadIdx.x; asm volatile("" : "+v"(tid_l_));
    const int tid = tid_l_, wid = __builtin_amdgcn_readfirstlane(tid >> 6), lane = tid & 63, wr = wid >> 2, wc = wid & 3, fr = lane & 15, fq = lane >> 4;
    const int K = g.K, nt = K / BK;
    unsigned voffA[2], voffB[2];
#pragma unroll
    for (int i = 0; i < 2; ++i) { int R, C; stage_rc(tid * 16 + i * 8192, R, C); const int Rb = Epi::PERM ? ((R & ~31) + perm32(R & 31)) : R;
        voffA[i] = (unsigned)(R * K + C) * 2u; voffB[i] = (unsigned)(Rb * K + C) * 2u; }
    const size_t kstep = (size_t)(BK * 2);
    const size_t hstep = (size_t)HALF * K * 2;
    const size_t tstep = 2 * hstep;
    const unsigned ldsw = (unsigned)wid * 1024u;
    const int aoff = lds_byte(wr * 64 + fr, fq * 8), boff = lds_byte(wc * 32 + fr, fq * 8);
#define PG8_SA(b, h) (((b) * 2 + (h)) * HTB)
#define PG8_SB(b, h) ((4 + (b) * 2 + (h)) * HTB)
#define PG8_STAGE(bufoff, gbase, voff) do { _Pragma("unroll") for (int _i = 0; _i < 2; ++_i) \
        __builtin_amdgcn_global_load_lds((const unsigned*)((const char*)(gbase) + (voff)[_i]), (PG8_LAS unsigned*)(lds + (bufoff) + ldsw + _i * 8192), 16, 0, 0); } while (0)
#define PG8_LDA(dst, b, h) do { _Pragma("unroll") for (int m = 0; m < 4; ++m) _Pragma("unroll") for (int k = 0; k < 2; ++k) dst[m][k] = *(const PG8_LAS bf16x8*)(lds + PG8_SA(b, h) + aoff + m * 2048 + k * 1024); } while (0)
#define PG8_LDB(dst, b, h) do { _Pragma("unroll") for (int n = 0; n < 2; ++n) _Pragma("unroll") for (int k = 0; k < 2; ++k) dst[n][k] = *(const PG8_LAS bf16x8*)(lds + PG8_SB(b, h) + boff + n * 2048 + k * 1024); } while (0)
#define PG8_MMA(ai, bj, At, Bt) do { __builtin_amdgcn_s_setprio(1); _Pragma("unroll") for (int m = 0; m < 4; ++m) _Pragma("unroll") for (int n = 0; n < 2; ++n) _Pragma("unroll") for (int k = 0; k < 2; ++k) \
        acc[ai][bj][m][n] = __builtin_amdgcn_mfma_f32_16x16x32_bf16(Bt[n][k], At[m][k], acc[ai][bj][m][n], 0, 0, 0); __builtin_amdgcn_s_setprio(0); } while (0)
#define PG8_WAIT_V(n) asm volatile("s_waitcnt vmcnt(" #n ")" ::: "memory")
#define PG8_WAIT_L(n) asm volatile("s_waitcnt lgkmcnt(" #n ")" ::: "memory")
#define PG8_BAR __builtin_amdgcn_s_barrier()
#define PG8_SCHED __builtin_amdgcn_sched_barrier(0)
    Unit cur, nxt; int ui = 0;
    if (!S.next(0, cur)) return;
    f32x4 acc[2][2][4][2];
#pragma unroll
    for (int a = 0; a < 2; ++a)
#pragma unroll
        for (int b = 0; b < 2; ++b)
#pragma unroll
            for (int m = 0; m < 4; ++m)
#pragma unroll
                for (int n = 0; n < 2; ++n) acc[a][b][m][n] = (f32x4){0.f, 0.f, 0.f, 0.f};
    bf16x8 At[4][2], B0[2][2], B1[2][2];
    const char* cA = (const char*)g.A + (size_t)cur.pm * tstep; const char* cB = (const char*)g.Bt + (size_t)cur.pn * tstep;
    S.a_ready(cur);
    if constexpr (SP2) {
        PG8_STAGE(PG8_SB(0, 0), cB, voffB); PG8_STAGE(PG8_SB(0, 1), cB + hstep, voffB); PG8_STAGE(PG8_SA(0, 0), cA, voffA); PG8_STAGE(PG8_SA(0, 1), cA + hstep, voffA);
        if (wr == 1) PG8_BAR;
        PG8_WAIT_V(2); PG8_BAR;
        PG8_STAGE(PG8_SB(1, 0), cB + kstep, voffB); PG8_STAGE(PG8_SA(1, 0), cA + kstep, voffA); PG8_STAGE(PG8_SB(1, 1), cB + hstep + kstep, voffB);
        PG8_WAIT_V(6); PG8_BAR;
    } else {
        PG8_STAGE(PG8_SB(0, 0), cB, voffB); PG8_STAGE(PG8_SA(0, 0), cA, voffA); PG8_STAGE(PG8_SB(0, 1), cB + hstep, voffB); PG8_STAGE(PG8_SA(0, 1), cA + hstep, voffA);
        if (wr == 1) PG8_BAR;
        PG8_WAIT_V(4); PG8_BAR;
        PG8_STAGE(PG8_SB(1, 0), cB + kstep, voffB); PG8_STAGE(PG8_SA(1, 0), cA + kstep, voffA); PG8_STAGE(PG8_SB(1, 1), cB + hstep + kstep, voffB);
        PG8_WAIT_V(6); PG8_BAR;
    }
    for (;;) {
        const bool has_next = S.next(ui + 1, nxt);
        const char* nA = has_next ? (const char*)g.A + (size_t)nxt.pm * tstep : cA; const char* nB = has_next ? (const char*)g.Bt + (size_t)nxt.pn * tstep : cB;
        for (int t = 0; t < nt; t += 2) {
            const bool last = (t == nt - 2);
            const char* a1 = cA + (size_t)(t + 1) * kstep;
            const char* a2 = last ? nA : cA + (size_t)(t + 2) * kstep; const char* b2 = last ? nB : cB + (size_t)(t + 2) * kstep;
            const char* a3 = a2 + kstep; const char* b3 = b2 + kstep;
            if (last && has_next) S.a_ready(nxt);
            if constexpr (SP2) {
            PG8_LDB(B0, 0, 0); PG8_LDB(B1, 0, 1); PG8_SCHED; PG8_LDA(At, 0, 0); PG8_STAGE(PG8_SA(1, 1), a1 + hstep, voffA);
            PG8_WAIT_V(8); PG8_WAIT_L(0); PG8_BAR; PG8_MMA(0, 0, At, B0); PG8_MMA(0, 1, At, B1); PG8_BAR; PG8_SCHED;
            PG8_LDA(At, 0, 1); PG8_STAGE(PG8_SB(0, 0), b2, voffB); PG8_STAGE(PG8_SB(0, 1), b2 + hstep, voffB); PG8_STAGE(PG8_SA(0, 0), a2, voffA);
            PG8_WAIT_V(8); PG8_WAIT_L(0); PG8_BAR; PG8_MMA(1, 0, At, B0); PG8_MMA(1, 1, At, B1); PG8_BAR; PG8_SCHED;
            PG8_LDB(B0, 1, 0); PG8_LDB(B1, 1, 1); PG8_SCHED; PG8_LDA(At, 1, 0); PG8_STAGE(PG8_SA(0, 1), a2 + hstep, voffA);
            PG8_WAIT_V(8); PG8_WAIT_L(0); PG8_BAR; PG8_MMA(0, 0, At, B0); PG8_MMA(0, 1, At, B1); PG8_BAR; PG8_SCHED;
            PG8_LDA(At, 1, 1); PG8_STAGE(PG8_SB(1, 0), b3, voffB); PG8_STAGE(PG8_SB(1, 1), b3 + hstep, voffB); PG8_STAGE(PG8_SA(1, 0), a3, voffA);
            PG8_WAIT_V(8); PG8_WAIT_L(0); PG8_BAR; PG8_MMA(1, 0, At, B0); PG8_MMA(1, 1, At, B1); PG8_BAR; PG8_SCHED;
            } else {
            PG8_LDB(B0, 0, 0); PG8_SCHED; PG8_LDA(At, 0, 0); PG8_STAGE(PG8_SA(1, 1), a1 + hstep, voffA);
            PG8_WAIT_L(8); PG8_BAR; PG8_WAIT_L(0); PG8_MMA(0, 0, At, B0); PG8_BAR; PG8_SCHED;
            PG8_LDB(B1, 0, 1); PG8_STAGE(PG8_SB(0, 0), b2, voffB);
            PG8_BAR; PG8_WAIT_L(0); PG8_MMA(0, 1, At, B1); PG8_BAR;
            PG8_LDA(At, 0, 1); PG8_STAGE(PG8_SA(0, 0), a2, voffA);
            PG8_BAR; PG8_WAIT_L(0); PG8_MMA(1, 0, At, B0); PG8_BAR; PG8_SCHED;
            PG8_STAGE(PG8_SB(0, 1), b2 + hstep, voffB);
            PG8_WAIT_V(6); PG8_BAR; PG8_MMA(1, 1, At, B1); PG8_BAR;
            PG8_LDB(B0, 1, 0); PG8_SCHED; PG8_LDA(At, 1, 0); PG8_STAGE(PG8_SA(0, 1), a2 + hstep, voffA);
            PG8_WAIT_L(8); PG8_BAR; PG8_WAIT_L(0); PG8_MMA(0, 0, At, B0); PG8_BAR; PG8_SCHED;
            PG8_LDB(B1, 1, 1); PG8_STAGE(PG8_SB(1, 0), b3, voffB);
            PG8_BAR; PG8_WAIT_L(0); PG8_MMA(0, 1, At, B1); PG8_BAR;
            PG8_LDA(At, 1, 1); PG8_STAGE(PG8_SA(1, 0), a3, voffA);
            PG8_BAR; PG8_WAIT_L(0); PG8_MMA(1, 0, At, B0); PG8_BAR; PG8_SCHED;
            PG8_STAGE(PG8_SB(1, 1), b3 + hstep, voffB);
            PG8_WAIT_V(6); PG8_BAR; PG8_MMA(1, 1, At, B1); PG8_BAR;
            }
        }
        if constexpr (ALIGN_EPI) { if (wr == 0) PG8_BAR; }
        if constexpr (!Epi::AFTER_DRAIN) { E(acc, cur, wr, wc, fr, fq); S.done(cur); }
        if (!has_next) break;
#pragma unroll
        for (int a = 0; a < 2; ++a)
#pragma unroll
            for (int b = 0; b < 2; ++b)
#pragma unroll
                for (int m = 0; m < 4; ++m)
#pragma unroll
                    for (int n = 0; n < 2; ++n) acc[a][b][m][n] = (f32x4){0.f, 0.f, 0.f, 0.f};
        cur = nxt; cA = nA; cB = nB; ++ui;
        if constexpr (ALIGN_EPI) { if (wr == 1) PG8_BAR; }
    }
    PG8_WAIT_V(0);
    if constexpr (!ALIGN_EPI) { if (wr == 0) PG8_BAR; }
    PG8_BAR;
    if constexpr (Epi::AFTER_DRAIN) { E.fused(acc, cur, wr, wc, fr, fq, lds, wid, lane); S.done(cur); }
#undef PG8_SA
#undef PG8_SB
#undef PG8_STAGE
#undef PG8_LDA
#undef PG8_LDB
#undef PG8_MMA
#undef PG8_WAIT_V
#undef PG8_WAIT_L
#undef PG8_BAR
#undef PG8_SCHED
}
}
#define LAS __attribute__((address_space(3)))
typedef unsigned short bf16;
typedef unsigned v4u __attribute__((ext_vector_type(4)));
typedef unsigned v2u __attribute__((ext_vector_type(2)));
typedef float f32x4 __attribute__((ext_vector_type(4)));
constexpr int NW = 8, NT = 512, GRID = 256;
constexpr int D = 1024, SEQ = 4096, NB = 4, CTX = 256, MLAT = NB * SEQ, MCTX = NB * CTX, MALL = MLAT + MCTX;
constexpr int NCH = MALL / 64, NCHL = MLAT / 64;
constexpr int LDP = 2880;
constexpr int PQ = 0, PK = 256, PV = 512, PR = 1024, PZ = 1536, PX = 2048, PLR = 2816, PDT = 2848;
constexpr int DFF = 2816, DIN = 2864;
constexpr float EPS = 1e-6f;
constexpr size_t MiB = 1u << 20;
constexpr size_t WS_MODP = 1 * MiB, WS_MODF = 14 * MiB;
constexpr size_t WS_WIN = 2 * MiB, WS_WOUT = 8 * MiB, WS_SMALL = 10 * MiB;
constexpr size_t WS_R1 = 16 * MiB, WS_PROJ = 50 * MiB, WS_G = 146 * MiB, WS_ST = 180 * MiB, WS_END = 248 * MiB;
constexpr size_t SM_DT = 0, SM_A = 2 * (size_t)MALL * 8 * 4, SM_DECG = 4 * (size_t)MALL * 8 * 4, SM_DECS = SM_DECG + (size_t)NCH * 2 * 256 * 4;
constexpr int LDS_BYTES = 147456;

struct Args { const float* in[28]; float* out; unsigned char* ws; };

__device__ __forceinline__ unsigned f2bf(float f) { unsigned u = __builtin_bit_cast(unsigned, f); return (u + 0x7fffu + ((u >> 16) & 1u)) >> 16; }
__device__ __forceinline__ unsigned pk2(float lo, float hi) { return f2bf(lo) | (f2bf(hi) << 16); }
__device__ __forceinline__ float bflo(unsigned u) { return __builtin_bit_cast(float, u << 16); }
__device__ __forceinline__ float bfhi(unsigned u) { return __builtin_bit_cast(float, u & 0xffff0000u); }
__device__ __forceinline__ float bf1(bf16 h) { return __builtin_bit_cast(float, ((unsigned)h) << 16); }
__device__ __forceinline__ float silu(float x) { return x * __builtin_amdgcn_rcpf(1.0f + __expf(-x)); }
__device__ __forceinline__ float logsigmoid(float x) { return fminf(x, 0.f) - log1pf(__expf(-fabsf(x))); }
__device__ __forceinline__ float softplus(float x) { return fmaxf(x, 0.f) + log1pf(__expf(-fabsf(x))); }
__device__ __forceinline__ float shx(float v, int o, int lane) { return __builtin_bit_cast(float, __builtin_amdgcn_ds_bpermute((lane ^ o) << 2, __builtin_bit_cast(int, v))); }
#define LDS_WAIT() asm volatile("s_waitcnt lgkmcnt(0)" ::: "memory")

__device__ __forceinline__ void transpose_item(const float* W, int K, int N, bf16* WT, int dst_row0, int k0, int n0, LAS float* scr, int lane) {
#pragma unroll
    for (int i = 0; i < 8; ++i) { const int kk = 8 * i + (lane >> 3), c4 = 4 * (lane & 7), n = n0 + c4;
        const f32x4 v = (n < N) ? *(const f32x4*)(W + (size_t)(k0 + kk) * N + n) : (f32x4){0.f, 0.f, 0.f, 0.f};
        scr[kk * 33 + c4] = v.x; scr[kk * 33 + c4 + 1] = v.y; scr[kk * 33 + c4 + 2] = v.z; scr[kk * 33 + c4 + 3] = v.w; }
    LDS_WAIT(); asm volatile("" ::: "memory");
    const int c = lane & 7;
#pragma unroll
    for (int j = 0; j < 4; ++j) { const int n = (lane >> 3) + 8 * j; const LAS float* s = scr + (8 * c) * 33 + n;
        v4u o; o.x = pk2(s[0 * 33], s[1 * 33]); o.y = pk2(s[2 * 33], s[3 * 33]); o.z = pk2(s[4 * 33], s[5 * 33]); o.w = pk2(s[6 * 33], s[7 * 33]);
        *(v4u*)(WT + (size_t)(dst_row0 + n) * K + k0 + 8 * c) = o; }
    LDS_WAIT(); asm volatile("" ::: "memory");
}

#define XB_TMO      128
#define XB_XCNT(j)  (256  + 64 * (j))
#define XB_XSUB(j)  (1280 + 64 * (j))
#define XB_XGEN(j)  (2304 + 64 * (j))
#define XB_TOP      3328
#define XB_TOPGEN   3392
#define XCD_BAR_WORDS 3456
#define XB_SPIN_CAP (1u << 18)

__device__ __forceinline__ unsigned xb_ld(unsigned* p)              { return __hip_atomic_load(p, __ATOMIC_RELAXED, __HIP_MEMORY_SCOPE_AGENT); }
__device__ __forceinline__ unsigned xb_add(unsigned* p, unsigned v) { return __hip_atomic_fetch_add(p, v, __ATOMIC_RELAXED, __HIP_MEMORY_SCOPE_AGENT); }
__device__ __forceinline__ unsigned xb_xcc_id() { return (unsigned)__builtin_amdgcn_s_getreg((3 << 11) | 20) & 0xFu; }
#define XB_SPIN(cond, bar) do { unsigned _sp = 0; while (cond) { __builtin_amdgcn_s_sleep(1); \
    if ((++_sp & 255u) == 0u) { if (xb_ld(&(bar)[XB_TMO])) break; if (_sp > XB_SPIN_CAP) { atomicAdd(&(bar)[XB_TMO], 1u); break; } } } } while (0)

struct XcdBarrier {
    unsigned* bar; unsigned x;
    volatile LAS unsigned* st;
};

__device__ __forceinline__ XcdBarrier xcd_barrier_post(unsigned* bar, volatile LAS unsigned* st) {
    XcdBarrier b; b.bar = bar; b.x = xb_xcc_id(); b.st = st;
    if (threadIdx.x == 0) (void)xb_add(&bar[XB_XCNT(b.x)], 1u);
    return b;
}
__device__ __forceinline__ void xcd_barrier_complete(unsigned* bar, unsigned x, unsigned& nloc, unsigned& nx) {
    const unsigned G = gridDim.x * gridDim.y * gridDim.z;
    unsigned sum, cnt, mine, sp = 0u;
    for (;;) {
        sum = 0u; cnt = 0u; mine = 0u;
#pragma unroll
        for (unsigned j = 0; j < 16; ++j) { const unsigned c = xb_ld(&bar[XB_XCNT(j)]); sum += c; cnt += (c > 0u) ? 1u : 0u; mine = (j == x) ? c : mine; }
        if (sum == G) break;
        __builtin_amdgcn_s_sleep(1);
        if ((++sp & 255u) == 0u) { if (xb_ld(&bar[XB_TMO])) break; if (sp > XB_SPIN_CAP) { atomicAdd(&bar[XB_TMO], 1u); break; } }
    }
    nloc = mine > 0u ? mine : 1u; nx = cnt > 0u ? cnt : 1u;
}

__device__ __forceinline__ void xcd_barrier(const XcdBarrier& b) {
    asm volatile("s_waitcnt vmcnt(0)" ::: "memory");
    __syncthreads();
    if (threadIdx.x == 0) {
        unsigned* bar = b.bar;
        __builtin_amdgcn_s_waitcnt(0);
        unsigned nloc = b.st[0], nx = b.st[1];
        if (nloc == 0u) { xcd_barrier_complete(bar, b.x, nloc, nx); b.st[0] = nloc; b.st[1] = nx; }
        const unsigned old = xb_add(&bar[XB_XSUB(b.x)], 1u);
        const unsigned gen = old / nloc;
        if (old + 1u == (gen + 1u) * nloc) {
            __builtin_amdgcn_fence(__ATOMIC_RELEASE, "agent");
            asm volatile("s_waitcnt vmcnt(0)" ::: "memory");
            const unsigned og = xb_add(&bar[XB_TOP], 1u);
            const unsigned tg = og / nx;
            if (og + 1u == (tg + 1u) * nx) xb_add(&bar[XB_TOPGEN], 1u);
            else XB_SPIN(xb_ld(&bar[XB_TOPGEN]) == tg, bar);
            __builtin_amdgcn_fence(__ATOMIC_ACQUIRE, "agent");
            xb_add(&bar[XB_XGEN(b.x)], 1u);
            asm volatile("s_waitcnt vmcnt(0)" ::: "memory");
        } else {
            XB_SPIN(xb_ld(&bar[XB_XGEN(b.x)]) == gen, bar);
            __builtin_amdgcn_fence(__ATOMIC_ACQUIRE, "agent");
            asm volatile("s_waitcnt vmcnt(0)" ::: "memory");
        }
    }
    __syncthreads();
}

__device__ __forceinline__ int chain_chunk(int b, int d, int st) {
    if (st < 4) return 256 + 4 * b + (d ? 3 - st : st);
    const int c = st - 4; return 64 * b + (d ? 63 - c : c);
}

typedef short bf16x8 __attribute__((ext_vector_type(8)));
#define MFMA16(a, b, c) __builtin_amdgcn_mfma_f32_16x16x32_bf16((a), (b), (c), 0, 0, 0)
constexpr int RS = 144;
__device__ __forceinline__ bf16x8 ldsfrag(LAS unsigned char* base, int row, int ks, int lq) { return *(const LAS bf16x8*)(base + row * RS + ks * 64 + lq * 16); }
__device__ __forceinline__ float bperm(float v, int srclane) { return __builtin_bit_cast(float, __builtin_amdgcn_ds_bpermute(srclane << 2, __builtin_bit_cast(int, v))); }

template <int PASS>
__device__ __forceinline__ void gla_unit(LAS unsigned char* lds, int ch, int h, const bf16* PROJ, const float* GT, bf16* STG, float* DECG, bf16* OMIX, const float* gla_norm) {
    int tid_o_ = threadIdx.x; asm volatile("" : "+v"(tid_o_)); const int tid = tid_o_, lane = tid & 63, wave = __builtin_amdgcn_readfirstlane(tid >> 6);
    const int lr = lane & 15, lq = lane >> 4;
    LAS unsigned char* QE0 = lds; LAS unsigned char* KE0 = lds + 9216; LAS unsigned char* QE1 = lds + 18432; LAS unsigned char* KE1 = lds + 27648;
    LAS unsigned char* KT0 = lds + 36864; LAS unsigned char* KT1 = lds + 46080; LAS unsigned char* VT = lds + 55296; LAS unsigned char* Pm = lds + 73728;
    LAS float* OFFS = (LAS float*)(lds + 82944); LAS float* RED = (LAS float*)(lds + 84992);
    const size_t m0 = (size_t)64 * ch;
    {
        const int kk = tid & 63, qt = (tid >> 6) & 3, d = tid >> 8;
        const float* gp = GT + ((size_t)d * MALL + m0 + 16 * qt) * 256 + h * 64 + kk;
        const bf16* qp = PROJ + (m0 + 16 * qt) * LDP + PQ + h * 64 + kk; const bf16* kp = PROJ + (m0 + 16 * qt) * LDP + PK + h * 64 + kk;
        float c[16], kv[16], qv[16];
#pragma unroll
        for (int jj = 0; jj < 16; ++jj) { c[jj] = gp[(size_t)jj * 256]; kv[jj] = bf1(kp[(size_t)jj * LDP]); if (PASS == 1) qv[jj] = bf1(qp[(size_t)jj * LDP]); }
        if (d == 0) {
#pragma unroll
            for (int jj = 1; jj < 16; ++jj) c[jj] += c[jj - 1];
        } else {
#pragma unroll
            for (int jj = 14; jj >= 0; --jj) c[jj] += c[jj + 1];
        }
        OFFS[(d * 4 + qt) * 64 + kk] = d ? c[0] : c[15];
        { const int vcol = tid & 127, q4 = tid >> 7; const bf16* vp = PROJ + (m0 + 16 * q4) * LDP + PV + h * 128 + vcol; unsigned short vv[16];
#pragma unroll
          for (int jj = 0; jj < 16; ++jj) vv[jj] = vp[(size_t)jj * LDP];
          v4u w0, w1; w0.x = vv[0] | ((unsigned)vv[1] << 16); w0.y = vv[2] | ((unsigned)vv[3] << 16); w0.z = vv[4] | ((unsigned)vv[5] << 16); w0.w = vv[6] | ((unsigned)vv[7] << 16);
          w1.x = vv[8] | ((unsigned)vv[9] << 16); w1.y = vv[10] | ((unsigned)vv[11] << 16); w1.z = vv[12] | ((unsigned)vv[13] << 16); w1.w = vv[14] | ((unsigned)vv[15] << 16);
          *(LAS v4u*)(VT + vcol * RS + q4 * 32) = w0; *(LAS v4u*)(VT + vcol * RS + q4 * 32 + 16) = w1; }
        __syncthreads();
        float off = 0.f, tot = 0.f;
#pragma unroll
        for (int q2 = 0; q2 < 4; ++q2) { const float t = OFFS[(d * 4 + q2) * 64 + kk]; tot += t; if (d ? (q2 > qt) : (q2 < qt)) off += t; }
        if (PASS == 0) {
            unsigned pk[8];
#pragma unroll
            for (int jj = 0; jj < 16; jj += 2) pk[jj >> 1] = pk2(kv[jj] * __expf(tot - (c[jj] + off)), kv[jj + 1] * __expf(tot - (c[jj + 1] + off)));
            LAS unsigned char* KT = d ? KT1 : KT0;
            *(LAS v4u*)(KT + kk * RS + qt * 32) = (v4u){pk[0], pk[1], pk[2], pk[3]}; *(LAS v4u*)(KT + kk * RS + qt * 32 + 16) = (v4u){pk[4], pk[5], pk[6], pk[7]};
            if (qt == 0) DECG[(size_t)(ch * 2 + d) * 256 + h * 64 + kk] = __expf(tot);
        } else {
            LAS unsigned char* QE = d ? QE1 : QE0; LAS unsigned char* KE = d ? KE1 : KE0;
#pragma unroll
            for (int jj = 0; jj < 16; ++jj) { const float cu = c[jj] + off; const int tok = 16 * qt + jj;
                *(LAS unsigned short*)(QE + tok * RS + kk * 2) = (unsigned short)f2bf(qv[jj] * __expf(cu)); *(LAS unsigned short*)(KE + tok * RS + kk * 2) = (unsigned short)f2bf(kv[jj] * __expf(-cu)); }
        }
    }
    if (PASS == 0) {
        __syncthreads();
        const int d = wave & 1, kt = wave >> 1; LAS unsigned char* KT = d ? KT1 : KT0;
        const bf16x8 a0 = ldsfrag(KT, 16 * kt + lr, 0, lq), a1 = ldsfrag(KT, 16 * kt + lr, 1, lq);
        bf16* sp = STG + (size_t)((ch * 4 + h) * 2 + d) * 8192;
#pragma unroll
        for (int vt = 0; vt < 8; ++vt) { pg8::f32x4 acc = {0.f, 0.f, 0.f, 0.f};
            acc = MFMA16(a0, ldsfrag(VT, 16 * vt + lr, 0, lq), acc); acc = MFMA16(a1, ldsfrag(VT, 16 * vt + lr, 1, lq), acc);
            v2u o; o.x = pk2(acc[0], acc[1]); o.y = pk2(acc[2], acc[3]); *(v2u*)(sp + (16 * vt + lr) * 64 + 16 * kt + 4 * lq) = o; }
        __syncthreads();
    } else {
        const int it = wave & 3, vh = wave >> 2;
        bf16x8 sf[2][4][2];
#pragma unroll
        for (int d = 0; d < 2; ++d)
#pragma unroll
            for (int v4 = 0; v4 < 4; ++v4)
#pragma unroll
                for (int ks = 0; ks < 2; ++ks) sf[d][v4][ks] = *(const bf16x8*)(STG + (size_t)((ch * 4 + h) * 2 + d) * 8192 + (16 * (4 * vh + v4) + lr) * 64 + 32 * ks + 8 * lq);
        __syncthreads();
        {
            const int ait = wave >> 1;
#pragma unroll
            for (int j2 = 0; j2 < 2; ++j2) { const int jt = 2 * (wave & 1) + j2; pg8::f32x4 af = {0.f, 0.f, 0.f, 0.f}, ab = {0.f, 0.f, 0.f, 0.f};
                if (jt <= ait) { af = MFMA16(ldsfrag(KE0, 16 * jt + lr, 0, lq), ldsfrag(QE0, 16 * ait + lr, 0, lq), af); af = MFMA16(ldsfrag(KE0, 16 * jt + lr, 1, lq), ldsfrag(QE0, 16 * ait + lr, 1, lq), af); }
                if (jt >= ait) { ab = MFMA16(ldsfrag(KE1, 16 * jt + lr, 0, lq), ldsfrag(QE1, 16 * ait + lr, 0, lq), ab); ab = MFMA16(ldsfrag(KE1, 16 * jt + lr, 1, lq), ldsfrag(QE1, 16 * ait + lr, 1, lq), ab); }
                const int i = 16 * ait + lr, j0 = 16 * jt + 4 * lq; float p[4];
#pragma unroll
                for (int r = 0; r < 4; ++r) p[r] = ((j0 + r <= i) ? af[r] : 0.f) + ((j0 + r >= i) ? ab[r] : 0.f);
                v2u o; o.x = pk2(p[0], p[1]); o.y = pk2(p[2], p[3]); *(LAS v2u*)(Pm + i * RS + j0 * 2) = o; }
        }
        __syncthreads();
        pg8::f32x4 acc[4];
#pragma unroll
        for (int v4 = 0; v4 < 4; ++v4) acc[v4] = (pg8::f32x4){0.f, 0.f, 0.f, 0.f};
#pragma unroll
        for (int ks = 0; ks < 2; ++ks) { const bf16x8 bp = ldsfrag(Pm, 16 * it + lr, ks, lq), b0 = ldsfrag(QE0, 16 * it + lr, ks, lq), b1 = ldsfrag(QE1, 16 * it + lr, ks, lq);
#pragma unroll
            for (int v4 = 0; v4 < 4; ++v4) { acc[v4] = MFMA16(ldsfrag(VT, 16 * (4 * vh + v4) + lr, ks, lq), bp, acc[v4]); acc[v4] = MFMA16(sf[0][v4][ks], b0, acc[v4]); acc[v4] = MFMA16(sf[1][v4][ks], b1, acc[v4]); } }
        float ss = 0.f;
#pragma unroll
        for (int v4 = 0; v4 < 4; ++v4) ss += (acc[v4][0] * acc[v4][0] + acc[v4][1] * acc[v4][1]) + (acc[v4][2] * acc[v4][2] + acc[v4][3] * acc[v4][3]);
        ss += bperm(ss, lane ^ 16); ss += bperm(ss, lane ^ 32);
        if (lq == 0) RED[wave * 16 + lr] = ss;
        __syncthreads();
        const float rstd = rsqrtf((RED[wave * 16 + lr] + RED[(wave ^ 4) * 16 + lr]) * (1.f / 128.f) + EPS);
        const size_t m = m0 + 16 * it + lr;
#pragma unroll
        for (int v4 = 0; v4 < 4; ++v4) { const int vcol = 16 * (4 * vh + v4) + 4 * lq; const v2u rr = *(const v2u*)(PROJ + m * LDP + PR + h * 128 + vcol); const f32x4 g = *(const f32x4*)(gla_norm + vcol);
            v2u o; o.x = pk2(acc[v4][0] * rstd * g.x * silu(bflo(rr.x)), acc[v4][1] * rstd * g.y * silu(bfhi(rr.x))); o.y = pk2(acc[v4][2] * rstd * g.z * silu(bflo(rr.y)), acc[v4][3] * rstd * g.w * silu(bfhi(rr.y)));
            *(v2u*)(OMIX + m * 1024 + h * 128 + vcol) = o; }
        __syncthreads();
    }
}

template <int PASS>
__device__ __forceinline__ void ssd_unit(LAS unsigned char* lds, int ch, int g, const bf16* PROJ, const bf16* XBC, const float* At, const float* DTt, bf16* STS, float* DECS, bf16* OMIX,
                                         const float* d_skip, const float* ssd_norm) {
    int tid_o_ = threadIdx.x; asm volatile("" : "+v"(tid_o_)); const int tid = tid_o_, lane = tid & 63, wave = __builtin_amdgcn_readfirstlane(tid >> 6);
    const int lr = lane & 15, lq = lane >> 4;
    LAS unsigned char* CM = lds; LAS unsigned char* BM = lds + 9216; LAS unsigned char* BT = lds + 18432; LAS unsigned char* XT = lds + 27648;
    LAS unsigned char* Mi = lds + 64512;
    LAS float* SC = (LAS float*)(lds + 101376); LAS float* DL = (LAS float*)(lds + 101376 + 2048); LAS float* TOT = (LAS float*)(lds + 101376 + 4096); LAS float* RED = (LAS float*)(lds + 107520);
    const size_t m0 = (size_t)64 * ch;
    {
        const int d = wave >> 2, hl = wave & 3; const size_t ix = ((size_t)d * MALL + m0 + lane) * 8 + 4 * g + hl;
        float v = At[ix]; const float dt = DTt[ix];
#pragma unroll
        for (int o = 1; o < 64; o <<= 1) { const float t = bperm(v, d ? lane + o : lane - o); if (d ? (lane + o < 64) : (lane >= o)) v += t; }
        SC[wave * 64 + lane] = v; DL[wave * 64 + lane] = dt;
        if (lane == (d ? 0 : 63)) TOT[wave] = v;
    }
    if (PASS == 0) {
        { const int n = tid & 63, oct = tid >> 6; const bf16* bp = XBC + (m0 + 8 * oct) * 768 + 512 + 64 * g + n; unsigned short vv[8];
#pragma unroll
          for (int jj = 0; jj < 8; ++jj) vv[jj] = bp[(size_t)jj * 768];
          *(LAS v4u*)(BT + n * RS + oct * 16) = (v4u){vv[0] | ((unsigned)vv[1] << 16), vv[2] | ((unsigned)vv[3] << 16), vv[4] | ((unsigned)vv[5] << 16), vv[6] | ((unsigned)vv[7] << 16)}; }
        __syncthreads();
        {
            const int p = tid & 63, hl = (tid >> 6) & 3, half = tid >> 8; const bf16* xp = XBC + (m0 + 32 * half) * 768 + (4 * g + hl) * 64 + p; float xv[32];
#pragma unroll
            for (int jj = 0; jj < 32; ++jj) xv[jj] = bf1(xp[(size_t)jj * 768]);
#pragma unroll
            for (int d = 0; d < 2; ++d) { const float tot = TOT[d * 4 + hl]; const LAS float* sc = SC + (d * 4 + hl) * 64 + 32 * half; const LAS float* dl = DL + (d * 4 + hl) * 64 + 32 * half;
                LAS unsigned char* dst = XT + ((d * 4 + hl) * 64 + p) * RS + half * 64;
#pragma unroll
                for (int o8 = 0; o8 < 4; ++o8) { unsigned pk[4];
#pragma unroll
                    for (int e = 0; e < 4; ++e) { const int j0 = 8 * o8 + 2 * e; pk[e] = pk2(xv[j0] * __expf(tot - sc[j0]) * dl[j0], xv[j0 + 1] * __expf(tot - sc[j0 + 1]) * dl[j0 + 1]); }
                    *(LAS v4u*)(dst + o8 * 16) = (v4u){pk[0], pk[1], pk[2], pk[3]}; } }
            if (tid < 8) DECS[(size_t)(ch * 2 + (tid >> 2)) * 8 + 4 * g + (tid & 3)] = __expf(TOT[tid]);
        }
        __syncthreads();
        {
            const int hh = 4 * g + (wave & 3), d = wave >> 2; LAS unsigned char* XW = XT + (wave * 64) * RS; bf16* sp = STS + (size_t)((ch * 8 + hh) * 2 + d) * 4096;
#pragma unroll
            for (int nt = 0; nt < 4; ++nt) { const bf16x8 a0 = ldsfrag(BT, 16 * nt + lr, 0, lq), a1 = ldsfrag(BT, 16 * nt + lr, 1, lq);
#pragma unroll
                for (int pt = 0; pt < 4; ++pt) { pg8::f32x4 acc = {0.f, 0.f, 0.f, 0.f};
                    acc = MFMA16(a0, ldsfrag(XW, 16 * pt + lr, 0, lq), acc); acc = MFMA16(a1, ldsfrag(XW, 16 * pt + lr, 1, lq), acc);
                    v2u o; o.x = pk2(acc[0], acc[1]); o.y = pk2(acc[2], acc[3]); *(v2u*)(sp + (16 * pt + lr) * 64 + 16 * nt + 4 * lq) = o; } }
        }
        __syncthreads();
    } else {
        {
#pragma unroll
            for (int i2 = 0; i2 < 2; ++i2) { const int idx = tid + NT * i2, tok = idx >> 4, c8 = (idx & 15) * 8;
                const v4u u = *(const v4u*)(XBC + (m0 + tok) * 768 + 512 + ((c8 < 64) ? 64 * g + c8 : 128 + 64 * g + (c8 - 64)));
                *(LAS v4u*)(((c8 < 64) ? BM : CM) + tok * RS + (c8 & 63) * 2) = u; }
            const int p = tid & 63, hl = (tid >> 6) & 3, half = tid >> 8; const bf16* xp = XBC + (m0 + 32 * half) * 768 + (4 * g + hl) * 64 + p; unsigned short xv[32];
#pragma unroll
            for (int jj = 0; jj < 32; ++jj) xv[jj] = xp[(size_t)jj * 768];
            LAS unsigned char* dst = XT + (hl * 64 + p) * RS + half * 64;
#pragma unroll
            for (int o8 = 0; o8 < 4; ++o8) *(LAS v4u*)(dst + o8 * 16) = (v4u){xv[8 * o8] | ((unsigned)xv[8 * o8 + 1] << 16), xv[8 * o8 + 2] | ((unsigned)xv[8 * o8 + 3] << 16), xv[8 * o8 + 4] | ((unsigned)xv[8 * o8 + 5] << 16), xv[8 * o8 + 6] | ((unsigned)xv[8 * o8 + 7] << 16)};
        }
        const int hl = wave >> 1, ih = wave & 1, hh = 4 * g + hl;
        bf16x8 sf[2][4][2];
#pragma unroll
        for (int d = 0; d < 2; ++d)
#pragma unroll
            for (int pt = 0; pt < 4; ++pt)
#pragma unroll
                for (int ks = 0; ks < 2; ++ks) sf[d][pt][ks] = *(const bf16x8*)(STS + (size_t)((ch * 8 + hh) * 2 + d) * 4096 + (16 * pt + lr) * 64 + 32 * ks + 8 * lq);
        __syncthreads();
        {
            const int ait = wave >> 1, i = 16 * ait + lr;
#pragma unroll
            for (int j2 = 0; j2 < 2; ++j2) { const int jt = 2 * (wave & 1) + j2, j0 = 16 * jt + 4 * lq; pg8::f32x4 cb = {0.f, 0.f, 0.f, 0.f};
                cb = MFMA16(ldsfrag(BM, 16 * jt + lr, 0, lq), ldsfrag(CM, 16 * ait + lr, 0, lq), cb); cb = MFMA16(ldsfrag(BM, 16 * jt + lr, 1, lq), ldsfrag(CM, 16 * ait + lr, 1, lq), cb);
#pragma unroll
                for (int h4 = 0; h4 < 4; ++h4) { const float sfi = SC[h4 * 64 + i], sbi = SC[(4 + h4) * 64 + i]; float p[4];
#pragma unroll
                    for (int r = 0; r < 4; ++r) { const int j = j0 + r; float w = 0.f;
                        if (j <= i) w += __expf(sfi - SC[h4 * 64 + j]) * DL[h4 * 64 + j];
                        if (j >= i) w += __expf(sbi - SC[(4 + h4) * 64 + j]) * DL[(4 + h4) * 64 + j];
                        p[r] = cb[r] * w; }
                    v2u o; o.x = pk2(p[0], p[1]); o.y = pk2(p[2], p[3]); *(LAS v2u*)(Mi + (h4 * 64 + i) * RS + j0 * 2) = o; } }
        }
        __syncthreads();
        LAS unsigned char* XTh = XT + (hl * 64) * RS; LAS unsigned char* Mh = Mi + (hl * 64) * RS;
        float rs2[2]; float yv[2][4][4];
#pragma unroll
        for (int i2 = 0; i2 < 2; ++i2) { const int it = 2 * ih + i2, i = 16 * it + lr; const size_t m = m0 + i;
            pg8::f32x4 ai[4], af[4], ab[4];
#pragma unroll
            for (int pt = 0; pt < 4; ++pt) { ai[pt] = (pg8::f32x4){0.f, 0.f, 0.f, 0.f}; af[pt] = ai[pt]; ab[pt] = ai[pt]; }
#pragma unroll
            for (int ks = 0; ks < 2; ++ks) { const bf16x8 bm = ldsfrag(Mh, i, ks, lq), bc = ldsfrag(CM, i, ks, lq);
#pragma unroll
                for (int pt = 0; pt < 4; ++pt) { ai[pt] = MFMA16(ldsfrag(XTh, 16 * pt + lr, ks, lq), bm, ai[pt]); af[pt] = MFMA16(sf[0][pt][ks], bc, af[pt]); ab[pt] = MFMA16(sf[1][pt][ks], bc, ab[pt]); } }
            const float ef = __expf(SC[hl * 64 + i]), eb = __expf(SC[(4 + hl) * 64 + i]), ds = d_skip[hh]; float ss = 0.f;
#pragma unroll
            for (int pt = 0; pt < 4; ++pt) { const int p0 = 16 * pt + 4 * lq; const v2u z = *(const v2u*)(PROJ + m * LDP + PZ + hh * 64 + p0);
                const float zz[4] = {bflo(z.x), bfhi(z.x), bflo(z.y), bfhi(z.y)};
#pragma unroll
                for (int r = 0; r < 4; ++r) { const float xs = bf1(*(const LAS unsigned short*)(XTh + (p0 + r) * RS + i * 2));
                    const float y = (ai[pt][r] + ef * af[pt][r] + eb * ab[pt][r] + ds * xs) * silu(zz[r]); yv[i2][pt][r] = y; ss += y * y; } }
            ss += bperm(ss, lane ^ 16); ss += bperm(ss, lane ^ 32);
            if (lq == 0) RED[wave * 32 + i2 * 16 + lr] = ss;
        }
        __syncthreads();
#pragma unroll
        for (int i2 = 0; i2 < 2; ++i2) { float t = 0.f;
#pragma unroll
            for (int h4 = 0; h4 < 4; ++h4) t += RED[(2 * h4 + ih) * 32 + i2 * 16 + lr];
            rs2[i2] = rsqrtf(t * (1.f / 256.f) + EPS); }
#pragma unroll
        for (int i2 = 0; i2 < 2; ++i2) { const size_t m = m0 + 16 * (2 * ih + i2) + lr;
#pragma unroll
            for (int pt = 0; pt < 4; ++pt) { const int col = 256 * g + 64 * hl + 16 * pt + 4 * lq; const f32x4 gn = *(const f32x4*)(ssd_norm + col);
                v2u o; o.x = pk2(yv[i2][pt][0] * rs2[i2] * gn.x, yv[i2][pt][1] * rs2[i2] * gn.y); o.y = pk2(yv[i2][pt][2] * rs2[i2] * gn.z, yv[i2][pt][3] * rs2[i2] * gn.w);
                *(v2u*)(OMIX + m * 1024 + 512 + col) = o; } }
        __syncthreads();
    }
}

__global__ void __launch_bounds__(NT, 2) fwd_kernel(Args args) {
    extern __shared__ __attribute__((aligned(16))) unsigned char lds_raw[];
    LAS unsigned char* lds = (LAS unsigned char*)lds_raw;
    const int bl = blockIdx.x; constexpr int NGW = GRID * NW;
    { volatile LAS unsigned* misc = (volatile LAS unsigned*)(lds + 131072 + 320); if (threadIdx.x < 32) misc[threadIdx.x] = 0u; }
    __syncthreads();
    const XcdBarrier gbar = xcd_barrier_post((unsigned*)(args.ws) + 4096, (volatile LAS unsigned*)(lds + 131072 + 320) + 8);
    if (PROBE_LO >= 0 && blockIdx.x == 0 && threadIdx.x == 0) ((volatile unsigned long long*)(args.ws + 524288))[0] = __builtin_amdgcn_s_memrealtime();
#define PHASE_IDS int tid_o_ = threadIdx.x; asm volatile("" : "+v"(tid_o_)); const int tid = tid_o_, lane = tid & 63, wave = __builtin_amdgcn_readfirstlane(tid >> 6), gw = bl * NW + wave; (void)lane; (void)wave; (void)gw;
    unsigned char* ws = args.ws;
    const float* x = args.in[0]; const float* cvec = args.in[1]; const float* ctx = args.in[2]; const float* c_ctx = args.in[3];
    const float* w_mod = args.in[4]; const float* b_mod = args.in[5];
    const float* g_mix_pre = args.in[6]; const float* g_mix_post = args.in[7]; const float* g_ffn_pre = args.in[8]; const float* g_ffn_post = args.in[9];
    const float* w_in = args.in[10]; const float* conv_w = args.in[11]; const float* conv_b = args.in[12];
    const float* wg_f = args.in[13]; const float* bg_f = args.in[14]; const float* wg_b = args.in[15]; const float* bg_b = args.in[16];
    const float* gla_norm = args.in[17]; const float* a_log_f = args.in[18]; const float* a_log_b = args.in[19];
    const float* dt_bias_f = args.in[20]; const float* dt_bias_b = args.in[21]; const float* d_skip = args.in[22]; const float* ssd_norm = args.in[23];
    const float* w_out = args.in[24]; const float* w_gate = args.in[25]; const float* w_up = args.in[26]; const float* w_down = args.in[27];
    float* out = args.out;
    float* MODP = (float*)(ws + WS_MODP); float* MODF = (float*)(ws + WS_MODF);
    bf16* Win_t = (bf16*)(ws + WS_WIN); bf16* Wout_t = (bf16*)(ws + WS_WOUT);
    bf16* Wgu_t = (bf16*)(ws + WS_G); bf16* Wdn_t = (bf16*)(ws + WS_G + 12 * MiB);
    bf16* H = (bf16*)out;
    bf16* R1 = (bf16*)(ws + WS_R1);
    bf16* PROJ = (bf16*)(ws + WS_PROJ);
    float* Yf = (float*)(ws + WS_PROJ);
    bf16* ACT = (bf16*)(ws + WS_PROJ);
    float* GT = (float*)(ws + WS_G);
    float* DTt = (float*)(ws + WS_SMALL + SM_DT);
    float* At = (float*)(ws + WS_SMALL + SM_A);
    float* DECG = (float*)(ws + WS_SMALL + SM_DECG);
    float* DECS = (float*)(ws + WS_SMALL + SM_DECS);
    bf16* STG = (bf16*)(ws + WS_ST);
    bf16* STS = (bf16*)(ws + WS_ST + 34 * MiB);
    float* Ff = (float*)(ws + WS_ST);

#ifndef NO_P0
    {
        PHASE_IDS
        for (int i = tid; i < 5 * 1024; i += NT) { const int r = i >> 10, k = i & 1023; const float v = (r < 4) ? cvec[r * 1024 + k] : c_ctx[k];
            ((LAS float*)(lds + 16384 * r + 12288))[k] = silu(v); }
        __syncthreads();
        LAS float* scr = (LAS float*)(lds + wave * 16384);
        constexpr int I_IN = 16 * 90, I_OUT = 16 * 32, I_MOD = 96 * 8;
        for (int it = gw; it < I_IN + I_OUT + I_MOD; it += NGW) {
            int r = it;
            if (r < I_IN) { const int kb = r / 90, nb = r % 90; const int dst = (nb < 48) ? 32 * nb : (nb == 48) ? 2816 : (nb < 89) ? 32 * (nb - 1) : 2848;
                transpose_item(w_in, 1024, DIN, Win_t, dst, 64 * kb, 32 * nb, scr, lane); continue; }
            r -= I_IN;
            if (r < I_OUT) { const int kb = r / 32, nb = r % 32; transpose_item(w_out, 1024, 1024, Wout_t, 32 * nb, 64 * kb, 32 * nb, scr, lane); continue; }
            r -= I_OUT;
            { const int ng = r % 96, ks = r / 96; const int n = 64 * ng + lane; float a0 = 0.f, a1 = 0.f, a2 = 0.f, a3 = 0.f, a4 = 0.f;
#pragma unroll 8
              for (int k = 128 * ks; k < 128 * ks + 128; ++k) { const float w = w_mod[(size_t)k * 6144 + n];
                  a0 += ((LAS float*)(lds + 16384 * 0 + 12288))[k] * w; a1 += ((LAS float*)(lds + 16384 * 1 + 12288))[k] * w; a2 += ((LAS float*)(lds + 16384 * 2 + 12288))[k] * w;
                  a3 += ((LAS float*)(lds + 16384 * 3 + 12288))[k] * w; a4 += ((LAS float*)(lds + 16384 * 4 + 12288))[k] * w; }
              float* p = MODP + (size_t)(ks * 5) * 6144 + n; p[0] = a0; p[6144] = a1; p[2 * 6144] = a2; p[3 * 6144] = a3; p[4 * 6144] = a4; }
        }
    }
#endif
    xcd_barrier(gbar);
    if (PROBE_LO >= 0 && blockIdx.x == 0 && threadIdx.x == 0) ((volatile unsigned long long*)(args.ws + 524288))[1] = __builtin_amdgcn_s_memrealtime();

#ifndef NO_P1
    {
        PHASE_IDS
        LAS float* T = (LAS float*)lds;
        const int b = bl >> 6;
        for (int i8 = 0; i8 < 8; ++i8) { const int i = tid + NT * i8; const int which = i >> 10, d = i & 1023, r = (which < 2) ? b : 4, e = (which & 1) * 1024 + d;
            float s = b_mod[e];
#pragma unroll
            for (int ks = 0; ks < 8; ++ks) s += MODP[(size_t)(ks * 5 + r) * 6144 + e];
            T[i] = s; }
        if (bl < 60) { const int e5 = bl * NT + tid, r = e5 / 6144, e = e5 % 6144; float s = b_mod[e];
#pragma unroll
            for (int ks = 0; ks < 8; ++ks) s += MODP[(size_t)(ks * 5 + r) * 6144 + e];
            MODF[e5] = s; }
        __syncthreads();
        _Pragma("unroll 1") for (int i = 0; i < 9; ++i) {
            int m; const float* src; int toff;
            if (i < 8) { m = 64 * bl + 8 * wave + i; src = x + (size_t)m * D; toff = 0; }
            else { if (wave >= 4) break; m = MLAT + 4 * bl + wave; src = ctx + (size_t)(4 * bl + wave) * D; toff = 2048; }
            f32x4 v[4]; float ss = 0.f;
#pragma unroll
            for (int j = 0; j < 4; ++j) { v[j] = *(const f32x4*)(src + 4 * (lane + 64 * j)); ss += (v[j].x * v[j].x + v[j].y * v[j].y) + (v[j].z * v[j].z + v[j].w * v[j].w); }
#pragma unroll
            for (int o = 1; o < 64; o <<= 1) ss += shx(ss, o, lane);
            const float rstd = rsqrtf(ss * (1.f / D) + EPS);
#pragma unroll
            for (int j = 0; j < 4; ++j) { const int d0 = 4 * (lane + 64 * j); const f32x4 g = *(const f32x4*)(g_mix_pre + d0);
                const f32x4 sh = *(LAS f32x4*)(T + toff + d0), sc = *(LAS f32x4*)(T + toff + 1024 + d0);
                const f32x4 h = (v[j] * rstd * g) * (sc + 1.0f) + sh;
                v2u w; w.x = pk2(h.x, h.y); w.y = pk2(h.z, h.w); *(v2u*)(H + (size_t)m * D + d0) = w; }
        }
    }
#endif
    xcd_barrier(gbar);
    if (PROBE_LO >= 0 && blockIdx.x == 0 && threadIdx.x == 0) ((volatile unsigned long long*)(args.ws + 524288))[2] = __builtin_amdgcn_s_memrealtime();

#ifndef NO_P2
    {
        pg8::Gemm g{H, Win_t, MALL, 2816, 1024}; pg8::StaticOrder S; S.init(MALL, 2816, GRID, bl);
        pg8::EpiProj E{PROJ};
        pg8::gemm_phase<pg8::EpiProj, pg8::StaticOrder, true, true>(lds, g, S, E);
    }
#endif
    xcd_barrier(gbar);
    if (PROBE_LO >= 0 && blockIdx.x == 0 && threadIdx.x == 0) ((volatile unsigned long long*)(args.ws + 524288))[3] = __builtin_amdgcn_s_memrealtime();

#ifndef NO_P3
    {
        PHASE_IDS
        bf16* XBC = R1;
        for (int it = bl; it < 816 + 2 * NCH; it += GRID) {
            PHASE_IDS
            if (it < 816) {
                const int ch = it / 3, third = it % 3, ch0 = third * 256 + 8 * (tid & 31), t0 = 4 * (tid >> 5);
                const bool lat = ch < NCHL; const int bb = lat ? (ch >> 6) : ((ch - 256) >> 2), cc = lat ? (ch & 63) : ((ch - 256) & 3);
                f32x4 w[9][2];
#pragma unroll
                for (int k9 = 0; k9 < 9; ++k9) { w[k9][0] = *(const f32x4*)(conv_w + k9 * 768 + ch0); w[k9][1] = *(const f32x4*)(conv_w + k9 * 768 + ch0 + 4); }
                const f32x4 cb0 = *(const f32x4*)(conv_b + ch0), cb1 = *(const f32x4*)(conv_b + ch0 + 4);
                v4u xr[3][6];
#pragma unroll
                for (int dr = 0; dr < 3; ++dr)
#pragma unroll
                    for (int c6 = 0; c6 < 6; ++c6) {
                        int mrow; bool ok;
                        if (lat) { const int rr = cc + dr - 1, tt = t0 + c6 - 1; ok = (rr >= 0) && (rr < 64) && (tt >= 0) && (tt < 64);
                            const int rc = rr < 0 ? 0 : (rr > 63 ? 63 : rr), tc = tt < 0 ? 0 : (tt > 63 ? 63 : tt); mrow = bb * SEQ + rc * 64 + tc; }
                        else { const int tt = cc * 64 + t0 + c6 - 1; ok = (dr == 1) && (tt >= 0) && (tt < 256); const int tc = tt < 0 ? 0 : (tt > 255 ? 255 : tt); mrow = MLAT + bb * CTX + tc; }
                        v4u xv = *(const v4u*)(PROJ + (size_t)mrow * LDP + PX + ch0);
                        xv.x = ok ? xv.x : 0u; xv.y = ok ? xv.y : 0u; xv.z = ok ? xv.z : 0u; xv.w = ok ? xv.w : 0u;
                        xr[dr][c6] = xv;
                    }
#pragma unroll
                for (int tk = 0; tk < 4; ++tk) {
                    float acc[8] = {cb0.x, cb0.y, cb0.z, cb0.w, cb1.x, cb1.y, cb1.z, cb1.w};
#pragma unroll
                    for (int dr = 0; dr < 3; ++dr)
#pragma unroll
                        for (int dc = 0; dc < 3; ++dc) { const v4u xv = xr[dr][tk + dc]; const f32x4 w0 = w[dr * 3 + dc][0], w1 = w[dr * 3 + dc][1];
                            acc[0] += w0.x * bflo(xv.x); acc[1] += w0.y * bfhi(xv.x); acc[2] += w0.z * bflo(xv.y); acc[3] += w0.w * bfhi(xv.y);
                            acc[4] += w1.x * bflo(xv.z); acc[5] += w1.y * bfhi(xv.z); acc[6] += w1.z * bflo(xv.w); acc[7] += w1.w * bfhi(xv.w); }
                    v4u o; o.x = pk2(silu(acc[0]), silu(acc[1])); o.y = pk2(silu(acc[2]), silu(acc[3])); o.z = pk2(silu(acc[4]), silu(acc[5])); o.w = pk2(silu(acc[6]), silu(acc[7]));
                    *(v4u*)(XBC + (size_t)(64 * ch + t0 + tk) * 768 + ch0) = o;
                }
            } else {
                const int gi = it - 816, ch = gi >> 1, th = gi & 1, tb = 64 * ch + 32 * th;
                LAS float* PART = (LAS float*)lds; LAS float* LR = (LAS float*)(lds + 49152); LAS float* DTR = (LAS float*)(lds + 53248);
                {
                    const int lr_ = lane & 15, lq_ = lane >> 4; pg8::f32x4 acc[2][3];
#pragma unroll
                    for (int rt = 0; rt < 2; ++rt)
#pragma unroll
                        for (int ct = 0; ct < 3; ++ct) acc[rt][ct] = (pg8::f32x4){0.f, 0.f, 0.f, 0.f};
                    const bf16* hp = H + (size_t)(tb + lr_) * D + 128 * wave + 8 * lq_; const bf16* wp = Win_t + (size_t)(2816 + lr_) * D + 128 * wave + 8 * lq_;
                    bf16x8 af[4][2], bfr[4][3];
#pragma unroll
                    for (int ks = 0; ks < 4; ++ks) {
#pragma unroll
                        for (int rt = 0; rt < 2; ++rt) af[ks][rt] = *(const bf16x8*)(hp + (size_t)(16 * rt) * D + 32 * ks);
#pragma unroll
                        for (int ct = 0; ct < 3; ++ct) bfr[ks][ct] = *(const bf16x8*)(wp + (size_t)(16 * ct) * D + 32 * ks); }
#pragma unroll
                    for (int ks = 0; ks < 4; ++ks)
#pragma unroll
                        for (int rt = 0; rt < 2; ++rt)
#pragma unroll
                            for (int ct = 0; ct < 3; ++ct) acc[rt][ct] = MFMA16(af[ks][rt], bfr[ks][ct], acc[rt][ct]);
#pragma unroll
                    for (int rt = 0; rt < 2; ++rt)
#pragma unroll
                        for (int ct = 0; ct < 3; ++ct)
#pragma unroll
                            for (int r = 0; r < 4; ++r) PART[(wave * 32 + 16 * rt + 4 * lq_ + r) * 48 + 16 * ct + lr_] = acc[rt][ct][r];
                }
                const int d = tid >> 8, col = tid & 255; const float* wg = d ? wg_b : wg_f; float wr[16];
#pragma unroll
                for (int r = 0; r < 16; ++r) wr[r] = wg[r * 256 + col];
                const float bg = (d ? bg_b : bg_f)[col]; float* Gd = GT + (size_t)d * MALL * 256;
                __syncthreads();
#pragma unroll
                for (int i = 0; i < 3; ++i) { const int idx = tid + NT * i, tok = idx / 48, col2 = idx % 48; float v = 0.f;
#pragma unroll
                    for (int w8 = 0; w8 < 8; ++w8) v += PART[(w8 * 32 + tok) * 48 + col2];
                    if (col2 < 32) LR[tok * 32 + col2] = v; else DTR[tok * 16 + col2 - 32] = v; }
                __syncthreads();
#pragma unroll 4
                for (int t = 0; t < 32; ++t) { float dot = bg; const LAS f32x4* lp = (const LAS f32x4*)(LR + t * 32 + 16 * d);
#pragma unroll
                    for (int r4 = 0; r4 < 4; ++r4) { const f32x4 l4 = lp[r4]; dot += l4.x * wr[4 * r4] + l4.y * wr[4 * r4 + 1] + l4.z * wr[4 * r4 + 2] + l4.w * wr[4 * r4 + 3]; }
                    Gd[(size_t)(tb + t) * 256 + col] = (fminf(dot, 0.f) - __logf(1.0f + __expf(-fabsf(dot)))) * (1.0f / 16.0f); }
                { const int tok = tid >> 4, dh = tid & 15, dd = dh >> 3, hh = dh & 7; const size_t m = tb + tok;
                    const float raw = DTR[tok * 16 + dh] + (dd ? dt_bias_b : dt_bias_f)[hh]; const float dt = fmaxf(raw, 0.f) + __logf(1.0f + __expf(-fabsf(raw)));
                    DTt[((size_t)dd * MALL + m) * 8 + hh] = dt; At[((size_t)dd * MALL + m) * 8 + hh] = -dt * __expf((dd ? a_log_b : a_log_f)[hh]); }
                __syncthreads();
            }
        }
    }
#endif
    xcd_barrier(gbar);
    if (PROBE_LO >= 0 && blockIdx.x == 0 && threadIdx.x == 0) ((volatile unsigned long long*)(args.ws + 524288))[4] = __builtin_amdgcn_s_memrealtime();

    bf16* OMIX = (bf16*)out;
    {
        const bf16* XBC = R1;
        _Pragma("unroll 1") for (int u = bl; u < 4 * NCH + 2 * NCH; u += GRID) {
            if (u < 4 * NCH) gla_unit<0>(lds, u >> 2, u & 3, PROJ, GT, STG, DECG, OMIX, gla_norm);
            else { const int v = u - 4 * NCH; ssd_unit<0>(lds, v >> 1, v & 1, PROJ, XBC, At, DTt, STS, DECS, OMIX, d_skip, ssd_norm); }
        }
    }
    xcd_barrier(gbar);
    if (PROBE_LO >= 0 && blockIdx.x == 0 && threadIdx.x == 0) ((volatile unsigned long long*)(args.ws + 524288))[5] = __builtin_amdgcn_s_memrealtime();
    {
        PHASE_IDS
        const int gt = bl * NT + tid;
        if (gt < 65536) {
            const int chain = gt >> 11, b = chain >> 3, h = (chain >> 1) & 3, d = chain & 1, e = 4 * (gt & 2047);
            float s0 = 0.f, s1 = 0.f, s2 = 0.f, s3 = 0.f;
            for (int st = 0; st < 68; st += 4) {
                v2u loc[4]; f32x4 dec[4]; bf16* ad[4];
#pragma unroll
                for (int u = 0; u < 4; ++u) { const int ch = chain_chunk(b, d, st + u); ad[u] = STG + (size_t)((ch * 4 + h) * 2 + d) * 8192 + e; loc[u] = *(const v2u*)ad[u];
                    dec[u] = *(const f32x4*)(DECG + (size_t)(ch * 2 + d) * 256 + h * 64 + (e & 63)); }
#pragma unroll
                for (int u = 0; u < 4; ++u) { v2u o; o.x = pk2(s0, s1); o.y = pk2(s2, s3); *(v2u*)ad[u] = o;
                    s0 = s0 * dec[u].x + bflo(loc[u].x); s1 = s1 * dec[u].y + bfhi(loc[u].x); s2 = s2 * dec[u].z + bflo(loc[u].y); s3 = s3 * dec[u].w + bfhi(loc[u].y); }
            }
        } else {
            const int g2 = gt - 65536, chain = g2 >> 10, b = chain >> 4, hh = (chain >> 1) & 7, d = chain & 1, e = 4 * (g2 & 1023);
            float s0 = 0.f, s1 = 0.f, s2 = 0.f, s3 = 0.f;
            for (int st = 0; st < 68; st += 4) {
                v2u loc[4]; float dec[4]; bf16* ad[4];
#pragma unroll
                for (int u = 0; u < 4; ++u) { const int ch = chain_chunk(b, d, st + u); ad[u] = STS + (size_t)((ch * 8 + hh) * 2 + d) * 4096 + e; loc[u] = *(const v2u*)ad[u];
                    dec[u] = DECS[(size_t)(ch * 2 + d) * 8 + hh]; }
#pragma unroll
                for (int u = 0; u < 4; ++u) { v2u o; o.x = pk2(s0, s1); o.y = pk2(s2, s3); *(v2u*)ad[u] = o;
                    s0 = s0 * dec[u] + bflo(loc[u].x); s1 = s1 * dec[u] + bfhi(loc[u].x); s2 = s2 * dec[u] + bflo(loc[u].y); s3 = s3 * dec[u] + bfhi(loc[u].y); }
            }
        }
    }
    xcd_barrier(gbar);
    if (PROBE_LO >= 0 && blockIdx.x == 0 && threadIdx.x == 0) ((volatile unsigned long long*)(args.ws + 524288))[6] = __builtin_amdgcn_s_memrealtime();
    {
        const bf16* XBC = R1;
        _Pragma("unroll 1") for (int u = bl; u < 4 * NCHL + 2 * NCHL; u += GRID) {
            if (u < 4 * NCHL) gla_unit<1>(lds, u >> 2, u & 3, PROJ, GT, STG, DECG, OMIX, gla_norm);
            else { const int v = u - 4 * NCHL; ssd_unit<1>(lds, v >> 1, v & 1, PROJ, XBC, At, DTt, STS, DECS, OMIX, d_skip, ssd_norm); }
        }
    }
    xcd_barrier(gbar);
    if (PROBE_LO >= 0 && blockIdx.x == 0 && threadIdx.x == 0) ((volatile unsigned long long*)(args.ws + 524288))[7] = __builtin_amdgcn_s_memrealtime();

#ifndef NO_P7
    {
        pg8::Gemm g{OMIX, Wout_t, MLAT, 1024, 1024}; pg8::StaticOrder S; S.init(MLAT, 1024, GRID, bl);
        pg8::EpiF32 E{Yf};
        pg8::gemm_phase<pg8::EpiF32, pg8::StaticOrder, true, true>(lds, g, S, E);
    }
#endif
    xcd_barrier(gbar);
    if (PROBE_LO >= 0 && blockIdx.x == 0 && threadIdx.x == 0) ((volatile unsigned long long*)(args.ws + 524288))[8] = __builtin_amdgcn_s_memrealtime();

#ifndef NO_P7b
    {
        PHASE_IDS
        LAS float* T = (LAS float*)lds;
        const int b = bl >> 6; bf16* H2 = R1;
        for (int i = tid; i < 3072; i += NT) T[i] = MODF[(size_t)b * 6144 + 2048 + i];
        __syncthreads();
        _Pragma("unroll 1") for (int i = 0; i < 8; ++i) {
            const int m = 64 * bl + 8 * wave + i;
            f32x4 v[4]; float ss = 0.f;
#pragma unroll
            for (int j = 0; j < 4; ++j) { v[j] = *(const f32x4*)(Yf + (size_t)m * D + 4 * (lane + 64 * j)); ss += (v[j].x * v[j].x + v[j].y * v[j].y) + (v[j].z * v[j].z + v[j].w * v[j].w); }
#pragma unroll
            for (int o = 1; o < 64; o <<= 1) ss += shx(ss, o, lane);
            const float rstd = rsqrtf(ss * (1.f / D) + EPS); float s2 = 0.f;
#pragma unroll
            for (int j = 0; j < 4; ++j) { const int d0 = 4 * (lane + 64 * j); const f32x4 g = *(const f32x4*)(g_mix_post + d0), xv = *(const f32x4*)(x + (size_t)m * D + d0), gt = *(LAS f32x4*)(T + d0);
                v[j] = xv + gt * (v[j] * rstd * g); *(f32x4*)(out + (size_t)m * D + d0) = v[j];
                s2 += (v[j].x * v[j].x + v[j].y * v[j].y) + (v[j].z * v[j].z + v[j].w * v[j].w); }
#pragma unroll
            for (int o = 1; o < 64; o <<= 1) s2 += shx(s2, o, lane);
            const float rstd2 = rsqrtf(s2 * (1.f / D) + EPS);
#pragma unroll
            for (int j = 0; j < 4; ++j) { const int d0 = 4 * (lane + 64 * j); const f32x4 g = *(const f32x4*)(g_ffn_pre + d0), sh = *(LAS f32x4*)(T + 1024 + d0), sc = *(LAS f32x4*)(T + 2048 + d0);
                const f32x4 h = (v[j] * rstd2 * g) * (sc + 1.0f) + sh; v2u w; w.x = pk2(h.x, h.y); w.y = pk2(h.z, h.w); *(v2u*)(H2 + (size_t)m * D + d0) = w; }
        }
        LAS float* scr = (LAS float*)(lds + wave * 16384);
        constexpr int I_G = 16 * 88, I_D = 44 * 32;
        for (int it = gw; it < 2 * I_G + I_D; it += NGW) {
            int r = it;
            if (r < 2 * I_G) { const int up = r >= I_G; if (up) r -= I_G; const int kb = r / 88, nb = r % 88;
                transpose_item(up ? w_up : w_gate, 1024, DFF, Wgu_t, 256 * (nb >> 2) + 32 * (nb & 3) + (up ? 128 : 0), 64 * kb, 32 * nb, scr, lane); continue; }
            r -= 2 * I_G;
            { const int kb = r / 32, nb = r % 32; transpose_item(w_down, DFF, 1024, Wdn_t, 32 * nb, 64 * kb, 32 * nb, scr, lane); }
        }
    }
#endif
    xcd_barrier(gbar);
    if (PROBE_LO >= 0 && blockIdx.x == 0 && threadIdx.x == 0) ((volatile unsigned long long*)(args.ws + 524288))[9] = __builtin_amdgcn_s_memrealtime();

#ifndef NO_P8
    {
        pg8::Gemm g{R1, Wgu_t, MLAT, 2 * DFF, 1024}; pg8::StaticOrder S; S.init(MLAT, 2 * DFF, GRID, bl);
        pg8::EpiSwiglu E{ACT};
        pg8::gemm_phase<pg8::EpiSwiglu, pg8::StaticOrder, true, true>(lds, g, S, E);
    }
#endif
    xcd_barrier(gbar);
    if (PROBE_LO >= 0 && blockIdx.x == 0 && threadIdx.x == 0) ((volatile unsigned long long*)(args.ws + 524288))[10] = __builtin_amdgcn_s_memrealtime();

#ifndef NO_P9
    {
        pg8::Gemm g{ACT, Wdn_t, MLAT, 1024, DFF}; pg8::StaticOrder S; S.init(MLAT, 1024, GRID, bl);
        pg8::EpiF32 E{Ff};
        pg8::gemm_phase<pg8::EpiF32, pg8::StaticOrder, true, true>(lds, g, S, E);
    }
#endif
    xcd_barrier(gbar);
    if (PROBE_LO >= 0 && blockIdx.x == 0 && threadIdx.x == 0) ((volatile unsigned long long*)(args.ws + 524288))[11] = __builtin_amdgcn_s_memrealtime();

#ifndef NO_P9b
    {
        PHASE_IDS
        LAS float* T = (LAS float*)lds; const int b = bl >> 6;
        for (int i = tid; i < 1024; i += NT) T[i] = MODF[(size_t)b * 6144 + 5 * 1024 + i];
        __syncthreads();
        _Pragma("unroll 1") for (int i = 0; i < 8; ++i) {
            const int m = 64 * bl + 8 * wave + i;
            f32x4 v[4]; float ss = 0.f;
#pragma unroll
            for (int j = 0; j < 4; ++j) { v[j] = *(const f32x4*)(Ff + (size_t)m * D + 4 * (lane + 64 * j)); ss += (v[j].x * v[j].x + v[j].y * v[j].y) + (v[j].z * v[j].z + v[j].w * v[j].w); }
#pragma unroll
            for (int o = 1; o < 64; o <<= 1) ss += shx(ss, o, lane);
            const float rstd = rsqrtf(ss * (1.f / D) + EPS);
#pragma unroll
            for (int j = 0; j < 4; ++j) { const int d0 = 4 * (lane + 64 * j); const f32x4 g = *(const f32x4*)(g_ffn_post + d0), xv = *(const f32x4*)(out + (size_t)m * D + d0), gt = *(LAS f32x4*)(T + d0);
                *(f32x4*)(out + (size_t)m * D + d0) = xv + gt * (v[j] * rstd * g); }
        }
    }
#endif
    if (PROBE_LO >= 0 && blockIdx.x == 0 && threadIdx.x == 0) {
        volatile unsigned long long* ts = (volatile unsigned long long*)(args.ws + 524288);
        const unsigned long long t12 = __builtin_amdgcn_s_memrealtime(); ts[12] = t12;
        const unsigned long long span = 8ull * (ts[PROBE_HI] - ts[PROBE_LO]);
        while (__builtin_amdgcn_s_memrealtime() - t12 < span) __builtin_amdgcn_s_sleep(8);
    }
}

extern "C" void kernel_launch(void* const* d_in, const int* in_sizes, int n_in, void* d_out, int out_size, void* d_ws, size_t ws_size, hipStream_t stream) {
    static int ready = 0;
    if (ready == 0) {
        if (n_in != 28 || out_size != MLAT * D || ws_size < WS_END) { fprintf(stderr, "kernel_launch: unexpected shapes (n_in %d out %d ws %zu)\n", n_in, out_size, ws_size); ready = -1; return; }
        if (hipFuncSetAttribute((const void*)fwd_kernel, hipFuncAttributeMaxDynamicSharedMemorySize, LDS_BYTES) != hipSuccess) { fprintf(stderr, "kernel_launch: hipFuncSetAttribute failed\n"); ready = -1; return; }
        int per_cu = 0, dev = 0, cus = 0; hipGetDevice(&dev); hipDeviceGetAttribute(&cus, hipDeviceAttributeMultiprocessorCount, dev);
        hipOccupancyMaxActiveBlocksPerMultiprocessor(&per_cu, (const void*)fwd_kernel, NT, LDS_BYTES);
        if (per_cu < 1 || cus < GRID) { fprintf(stderr, "kernel_launch: occupancy %d blocks/CU on %d CUs: cannot co-reside %d blocks\n", per_cu, cus, GRID); ready = -1; return; }
        (void)hipGetLastError();
        ready = 1;
    }
    if (ready < 0) return;
    Args a{};
    for (int i = 0; i < 28; ++i) a.in[i] = (const float*)d_in[i];
    a.out = (float*)d_out; a.ws = (unsigned char*)d_ws;
    if (hipMemsetAsync(d_ws, 0, 1 << 20, stream) != hipSuccess) { fprintf(stderr, "kernel_launch: memset failed\n"); return; }
    hipLaunchKernelGGL(fwd_kernel, dim3(GRID), dim3(NT), LDS_BYTES, stream, a);
    const hipError_t e = hipPeekAtLastError();
    if (e != hipSuccess) fprintf(stderr, "kernel_launch: launch failed: %s\n", hipGetErrorString(e));
}
```
